# Optimizing an MI355X kernel written in HIP

```python
import math
import jax, jax.numpy as jnp
from jax import lax
import numpy as np

D_MODEL = 4096
BATCH = 4
SEQ = 4096
DEPTH = 4

HEAD_DIM = 128
BLOCK = 128
ROPE_THETA = 10000.0
EPS = 1e-6
SWA_Q_HEADS = 16
SWA_KV_HEADS = 4
WINDOW = 128
N_BAND = -(-WINDOW // BLOCK) + 1
SB_HEADS = 8
DIFF_HEADS = 8
DIFF_QK_DIM = HEAD_DIM // 2
DIFF_NORM_EPS = 1e-5
D_FF = 4096
N_BRANCH = 3

SWA_Q_W = SWA_Q_HEADS * HEAD_DIM
SWA_KV_W = SWA_KV_HEADS * HEAD_DIM
SB_W = SB_HEADS * HEAD_DIM
DIFF_W = DIFF_HEADS * HEAD_DIM
QKV_WIDTHS = (SWA_Q_W, SWA_KV_W, SWA_KV_W, SB_W, SB_W, SB_W, DIFF_W, DIFF_W, DIFF_W)
QKV_W = sum(QKV_WIDTHS)

kernel_name = "hybrid_gated_swa_stickbreak_diffattn_macaron"


def rms_norm(x, g, eps=EPS):
    xf = x.astype(jnp.float32)
    y = xf * lax.rsqrt(jnp.mean(xf * xf, axis=-1, keepdims=True) + eps)
    return (y * g.astype(jnp.float32)).astype(x.dtype)


def swiglu(x, w_in, w_out):
    gu = x @ w_in
    g, u = jnp.split(gu, 2, axis=-1)
    return (jax.nn.silu(g) * u) @ w_out


def rope_tables(seq, dim):
    inv = 1.0 / (ROPE_THETA ** (jnp.arange(0, dim, 2, dtype=jnp.float32) / dim))
    ang = jnp.arange(seq, dtype=jnp.float32)[:, None] * inv[None, :]
    return jnp.cos(ang), jnp.sin(ang)


def apply_rope(x, cos, sin):
    xf = x.astype(jnp.float32)
    half = xf.shape[-1] // 2
    x1, x2 = xf[..., :half], xf[..., half:]
    c, s = cos[:, None, :], sin[:, None, :]
    return jnp.concatenate([x1 * c - x2 * s, x2 * c + x1 * s], axis=-1).astype(x.dtype)


def sliding_window_gqa(q, k, v, sinks):
    b, s, hq, d = q.shape
    hkv = k.shape[2]
    g = hq // hkv
    nb = s // BLOCK
    qb = q.reshape(b, nb, BLOCK, hkv, g, d)

    def band(t):
        tb = t.reshape(b, nb, BLOCK, hkv, d)
        tp = jnp.pad(tb, ((0, 0), (N_BAND - 1, 0), (0, 0), (0, 0), (0, 0)))
        return jnp.concatenate([tp[:, j:j + nb] for j in range(N_BAND)], axis=2)

    kk, vv = band(k), band(v)
    scores = jnp.einsum('bnqhgd,bnkhd->bnhgqk', qb, kk,
                        preferred_element_type=jnp.float32) * (1.0 / math.sqrt(d))
    qi = jnp.arange(BLOCK)[:, None]
    kj = jnp.arange(N_BAND * BLOCK)[None, :]
    rel = qi - kj + (N_BAND - 1) * BLOCK
    key_pos = (jnp.arange(nb)[:, None, None] - (N_BAND - 1)) * BLOCK + kj[None]
    valid = (rel >= 0)[None] & (rel < WINDOW)[None] & (key_pos >= 0)
    scores = jnp.where(valid[None, :, None, None], scores, -jnp.inf)
    sink = jnp.broadcast_to(sinks.astype(jnp.float32).reshape(1, 1, hkv, g, 1, 1),
                            scores.shape[:-1] + (1,))
    probs = jax.nn.softmax(jnp.concatenate([scores, sink], axis=-1), axis=-1)[..., :-1]
    out = jnp.einsum('bnhgqk,bnkhd->bnqhgd', probs.astype(v.dtype), vv)
    return out.reshape(b, s, hq * d)


def stick_breaking_attention(q, k, v):
    b, s, h, d = q.shape
    nb = s // BLOCK
    qb = q.reshape(b, nb, BLOCK, h, d).transpose(1, 0, 2, 3, 4)
    key_idx = jnp.arange(s)

    def one_block(args):
        i, qblk = args
        z = jnp.einsum('bqhd,bkhd->bhqk', qblk, k,
                       preferred_element_type=jnp.float32) * (1.0 / math.sqrt(d))
        t = i * BLOCK + jnp.arange(BLOCK)
        causal = key_idx[None, :] < t[:, None]
        log_beta = jax.nn.log_sigmoid(z)
        log_1m = jnp.where(causal, jax.nn.log_sigmoid(-z), 0.0)
        after = lax.cumsum(log_1m, axis=3, reverse=True) - log_1m
        a = jnp.where(causal, jnp.exp(log_beta + after), 0.0)
        return jnp.einsum('bhqk,bkhd->bqhd', a.astype(v.dtype), v)

    out = lax.map(one_block, (jnp.arange(nb), qb))
    return out.transpose(1, 0, 2, 3, 4).reshape(b, s, h * d)


def differential_attention(q, k, v, lam):
    b, s, h, _, dh = q.shape
    nb = s // BLOCK
    qb = q.reshape(b, nb, BLOCK, h, 2, dh).transpose(1, 0, 2, 3, 4, 5)
    key_idx = jnp.arange(s)

    def one_block(args):
        i, qblk = args
        sc = jnp.einsum('bqhcd,bkhcd->bhcqk', qblk, k,
                        preferred_element_type=jnp.float32) * (1.0 / math.sqrt(dh))
        t = i * BLOCK + jnp.arange(BLOCK)
        causal = key_idx[None, :] <= t[:, None]
        p = jax.nn.softmax(jnp.where(causal, sc, -jnp.inf), axis=-1)
        w = p[:, :, 0] - lam * p[:, :, 1]
        return jnp.einsum('bhqk,bkhd->bqhd', w.astype(v.dtype), v)

    out = lax.map(one_block, (jnp.arange(nb), qb))
    return out.transpose(1, 0, 2, 3, 4).reshape(b, s, h, v.shape[-1])


def setup_inputs(seed: int = 0) -> dict:
    key = jax.random.key(seed)
    ks = iter(jax.random.split(key, 32))
    f32 = jnp.float32

    def w(shape, fan_in):
        return jax.random.normal(next(ks), shape, f32) * (fan_in ** -0.5)

    def gain(shape):
        return 1.0 + 0.02 * jax.random.normal(next(ks), shape, f32)

    return {
        "x": jax.random.normal(next(ks), (BATCH, SEQ, D_MODEL), f32),
        "ffn1_norm": gain((DEPTH, D_MODEL)),
        "ffn1_w_in": w((DEPTH, D_MODEL, 2 * D_FF), D_MODEL),
        "ffn1_w_out": w((DEPTH, D_FF, D_MODEL), D_FF),
        "mix_norm": gain((DEPTH, D_MODEL)),
        "w_qkv": w((DEPTH, D_MODEL, QKV_W), D_MODEL),
        "w_gate": w((DEPTH, D_MODEL, N_BRANCH * D_MODEL), D_MODEL),
        "sinks": 0.5 * jax.random.normal(next(ks), (DEPTH, SWA_Q_HEADS), f32),
        "lambda_q1": 0.1 * jax.random.normal(next(ks), (DEPTH, DIFF_QK_DIM), f32),
        "lambda_k1": 0.1 * jax.random.normal(next(ks), (DEPTH, DIFF_QK_DIM), f32),
        "lambda_q2": 0.1 * jax.random.normal(next(ks), (DEPTH, DIFF_QK_DIM), f32),
        "lambda_k2": 0.1 * jax.random.normal(next(ks), (DEPTH, DIFF_QK_DIM), f32),
        "diff_norm": gain((DEPTH, HEAD_DIM)),
        "w_branch_a": w((DEPTH, SWA_Q_W, D_MODEL), SWA_Q_W),
        "w_branch_b": w((DEPTH, SB_W, D_MODEL), SB_W),
        "w_branch_c": w((DEPTH, DIFF_W, D_MODEL), DIFF_W),
        "w_out": w((DEPTH, D_MODEL, D_MODEL), D_MODEL),
        "ffn2_norm": gain((DEPTH, D_MODEL)),
        "ffn2_w_in": w((DEPTH, D_MODEL, 2 * D_FF), D_MODEL),
        "ffn2_w_out": w((DEPTH, D_FF, D_MODEL), D_FF),
        "final_norm": gain((D_MODEL,)),
    }


def reference(x, ffn1_norm, ffn1_w_in, ffn1_w_out, mix_norm, w_qkv, w_gate, sinks,
              lambda_q1, lambda_k1, lambda_q2, lambda_k2, diff_norm,
              w_branch_a, w_branch_b, w_branch_c, w_out,
              ffn2_norm, ffn2_w_in, ffn2_w_out, final_norm):
    b, s, _ = x.shape
    cos_a, sin_a = rope_tables(s, HEAD_DIM)
    cos_c, sin_c = rope_tables(s, DIFF_QK_DIM)
    split_idx = [int(i) for i in np.cumsum(QKV_WIDTHS)[:-1]]

    for l in range(DEPTH):
        x = x + 0.5 * swiglu(rms_norm(x, ffn1_norm[l]), ffn1_w_in[l], ffn1_w_out[l])

        h = rms_norm(x, mix_norm[l])
        qkv = h @ w_qkv[l]
        qa, ka, va, qb, kb, vb, qc, kc, vc = jnp.split(qkv, split_idx, axis=-1)

        qa = apply_rope(qa.reshape(b, s, SWA_Q_HEADS, HEAD_DIM), cos_a, sin_a)
        ka = apply_rope(ka.reshape(b, s, SWA_KV_HEADS, HEAD_DIM), cos_a, sin_a)
        va = va.reshape(b, s, SWA_KV_HEADS, HEAD_DIM)
        out_a = sliding_window_gqa(qa, ka, va, sinks[l])

        out_b = stick_breaking_attention(qb.reshape(b, s, SB_HEADS, HEAD_DIM),
                                         kb.reshape(b, s, SB_HEADS, HEAD_DIM),
                                         vb.reshape(b, s, SB_HEADS, HEAD_DIM))

        qc = apply_rope(qc.reshape(b, s, DIFF_HEADS * 2, DIFF_QK_DIM), cos_c, sin_c)
        kc = apply_rope(kc.reshape(b, s, DIFF_HEADS * 2, DIFF_QK_DIM), cos_c, sin_c)
        qc = qc.reshape(b, s, DIFF_HEADS, 2, DIFF_QK_DIM)
        kc = kc.reshape(b, s, DIFF_HEADS, 2, DIFF_QK_DIM)
        vc = vc.reshape(b, s, DIFF_HEADS, HEAD_DIM)
        lam_init = 0.8 - 0.6 * math.exp(-0.3 * l)
        lam = (jnp.exp(jnp.sum(lambda_q1[l].astype(jnp.float32) * lambda_k1[l].astype(jnp.float32)))
               - jnp.exp(jnp.sum(lambda_q2[l].astype(jnp.float32) * lambda_k2[l].astype(jnp.float32)))
               + lam_init)
        oc = differential_attention(qc, kc, vc, lam)
        oc = rms_norm(oc, diff_norm[l], DIFF_NORM_EPS) * (1.0 - lam_init)
        out_c = oc.reshape(b, s, DIFF_W).astype(x.dtype)

        gates = jax.nn.sigmoid((h @ w_gate[l]).astype(jnp.float32)).astype(x.dtype)
        g_a, g_b, g_c = jnp.split(gates, N_BRANCH, axis=-1)
        merged = (g_a * (out_a @ w_branch_a[l])
                  + g_b * (out_b @ w_branch_b[l])
                  + g_c * (out_c @ w_branch_c[l]))
        x = x + merged @ w_out[l]

        x = x + 0.5 * swiglu(rms_norm(x, ffn2_norm[l]), ffn2_w_in[l], ffn2_w_out[l])

    return rms_norm(x, final_norm)
```

```cpp
#include <hip/hip_runtime.h>
#include <cstdio>
#include <cstdint>

#ifndef MK_PER_PHASE
#define MK_PER_PHASE 0
#endif

namespace pg8 {
#define PG8_LAS __attribute__((address_space(3)))
typedef unsigned short bf16_t;
typedef short bf16x8 __attribute__((ext_vector_type(8)));
typedef float f32x4 __attribute__((ext_vector_type(4)));
typedef unsigned u32x4 __attribute__((ext_vector_type(4)));
constexpr int BM = 256, BK = 64, HALF = 128, HTB = HALF * BK * 2  , STAGE_BYTES = 8 * HTB, NXCD = 8, WGM = 8;

__host__ __device__ __forceinline__ int lds_byte(int r, int c) { const int st = (r >> 4) * 2 + (c >> 5), rr = r & 15, cc = c & 31, ob = rr * 64 + cc * 2; return st * 1024 + (ob ^ (((ob >> 9) & 1) << 5)); }
__host__ __device__ __forceinline__ void stage_rc(int b, int& R, int& C) { const int st = b / 1024, sb = b % 1024, swz = sb ^ (((sb >> 9) & 1) << 5); R = (st >> 1) * 16 + swz / 64; C = (st & 1) * 32 + (swz % 64) / 2; }
__host__ __device__ __forceinline__ int perm32(int rho) { const int n = rho >> 4, i = rho & 15; return 8 * (i >> 2) + 4 * n + (i & 3); }

__device__ __forceinline__ int launder_v(int x) { asm volatile("" : "+v"(x)); return x; }
__device__ __forceinline__ int lane_id() { int x; asm volatile("v_mbcnt_lo_u32_b32 %0, -1, 0\n\tv_mbcnt_hi_u32_b32 %0, -1, %0" : "=v"(x)); return x; }
template <int O> __device__ __forceinline__ float xor_lt32(float v) { return __int_as_float(__builtin_amdgcn_ds_swizzle(__float_as_int(v), (O << 10) | 0x1f)); }
__device__ __forceinline__ float xor32(float v, int hi) { const auto rr = __builtin_amdgcn_permlane32_swap(__float_as_uint(v), __float_as_uint(v), false, false); return __uint_as_float(hi ? rr[0] : rr[1]); }
__device__ __forceinline__ float sum32(float v) { const auto rr = __builtin_amdgcn_permlane32_swap(__float_as_uint(v), __float_as_uint(v), false, false); return __uint_as_float(rr[0]) + __uint_as_float(rr[1]); }
__device__ __forceinline__ float max32(float v) { const auto rr = __builtin_amdgcn_permlane32_swap(__float_as_uint(v), __float_as_uint(v), false, false); return fmaxf(__uint_as_float(rr[0]), __uint_as_float(rr[1])); }
struct Unit { int pm, pn; };
struct Gemm { const bf16_t* A; const bf16_t* Bt; int M, N, K; };

struct StaticOrder {
    int nM, nN, nwg, G, c;
    __host__ __device__ void init(int M, int N, int G_, int c_) { nM = M / BM; nN = N / BM; nwg = nM * nN; G = G_; c = c_; }
    __host__ __device__ bool next(int i, Unit& u) const {
        const long L = (long)i * G + c; if (L >= nwg) return false;
        int wgid = (int)L; { const int q = nwg / NXCD, r = nwg % NXCD, xcd = wgid % NXCD, off = wgid / NXCD; wgid = (xcd < r ? xcd * (q + 1) : r * (q + 1) + (xcd - r) * q) + off; }
        const int nig = WGM * nN, gid = wgid / nig, fm = gid * WGM, gsz = (nM - fm) < WGM ? (nM - fm) : WGM;
        u.pm = fm + ((wgid % nig) % gsz); u.pn = (wgid % nig) / gsz;
        { const int rot = (c % NXCD) * (nN / NXCD); u.pn += rot; if (u.pn >= nN) u.pn -= nN; }
        return true;
    }
    __device__ __forceinline__ void a_ready(const Unit&) const {}
    __device__ __forceinline__ void done(const Unit&) const {}
};

typedef float f32x2_t __attribute__((ext_vector_type(2))); typedef __bf16 bf16x2_t __attribute__((ext_vector_type(2)));
__device__ __forceinline__ unsigned cvt_pk_bf16(float lo, float hi) { const f32x2_t v = {lo, hi}; const bf16x2_t b = __builtin_convertvector(v, bf16x2_t); return __builtin_bit_cast(unsigned, b); }
__device__ __forceinline__ u32x4 pack8(const f32x4 v0, const f32x4 v1) { u32x4 w; w.x = cvt_pk_bf16(v0[0], v0[1]); w.y = cvt_pk_bf16(v0[2], v0[3]); w.z = cvt_pk_bf16(v1[0], v1[1]); w.w = cvt_pk_bf16(v1[2], v1[3]); return w; }
__device__ __forceinline__ float bflo(unsigned w) { return __uint_as_float(w << 16); }
__device__ __forceinline__ float bfhi(unsigned w) { return __uint_as_float(w & 0xffff0000u); }
__device__ __forceinline__ float sigm(float x) { return __builtin_amdgcn_rcpf(1.0f + __builtin_amdgcn_exp2f(-1.44269504089f * x)); }
constexpr float SS_SCALE = 1048576.0f;
__device__ __forceinline__ float rstd_from(const unsigned long long* ss, int row, float eps) { return rsqrtf((float)ss[row] * (1.0f / (SS_SCALE * 4096.0f)) + eps); }
constexpr float RMS_EPS = 1e-6f;
struct RowScales { float rs[8]; int pm;
    __device__ __forceinline__ void load(const unsigned long long* ss, int pm_, int wid, int lane, float mul) { pm = pm_; const int row0 = pm_ * BM + (wid >> 2) * 64 + (lane & 15);
#pragma unroll
        for (int j = 0; j < 8; ++j) rs[j] = rstd_from(ss, row0 + (j >> 2) * HALF + (j & 3) * 16, RMS_EPS) * mul; }
    __device__ __forceinline__ float get(const unsigned long long* ss, const Unit& u, int ai, int m, int row, float mul) const { return u.pm == pm ? rs[ai * 4 + m] : rstd_from(ss, row, RMS_EPS) * mul; }
};

__device__ __forceinline__ unsigned pk4_fp8(float a, float b, float c, float d) { int w = 0; w = __builtin_amdgcn_cvt_pk_fp8_f32(a, b, w, false); w = __builtin_amdgcn_cvt_pk_fp8_f32(c, d, w, true); return (unsigned)w; }
template <bool H8> struct EpiSwigluT {
    static constexpr bool PERM = true, AFTER_DRAIN = false;
    bf16_t* H; const unsigned long long* ss; RowScales R; float mul;
    __device__ __forceinline__ void operator()(const f32x4 (&acc)[2][2][4][2], const Unit& u, int wr, int wc, int fr_, int fq_) const {
        const int fr = launder_v(fr_), fq = launder_v(fq_);
        const int row0 = u.pm * BM + wr * 64 + fr, col0 = u.pn * HALF + wc * 32 + 8 * fq;
#pragma unroll
        for (int ai = 0; ai < 2; ++ai)
#pragma unroll
            for (int m = 0; m < 4; ++m) { const int row = row0 + ai * HALF + m * 16; const float rs = R.get(ss, u, ai, m, row, mul), rl = rs * -1.44269504089f, iq = __builtin_amdgcn_rcpf(rs * rs);
                f32x4 h[2];
#pragma unroll
                for (int n = 0; n < 2; ++n)
#pragma unroll
                    for (int i = 0; i < 4; ++i) { const float ag = acc[ai][0][m][n][i]; h[n][i] = (ag * acc[ai][1][m][n][i]) * __builtin_amdgcn_rcpf(__builtin_fmaf(__builtin_amdgcn_exp2f(ag * rl), iq, iq)); }
                if constexpr (H8) { typedef unsigned u32x2 __attribute__((ext_vector_type(2))); u32x2 w8; w8.x = pk4_fp8(h[0][0], h[0][1], h[0][2], h[0][3]); w8.y = pk4_fp8(h[1][0], h[1][1], h[1][2], h[1][3]);
                    *(u32x2*)((unsigned char*)H + (size_t)row * 4096 + col0) = w8; }
                else *(u32x4*)(H + (size_t)row * 4096 + col0) = pack8(h[0], h[1]); }
    }
};
typedef EpiSwigluT<false> EpiSwiglu;
__device__ __forceinline__ void unpack8(const u32x4 w, f32x4& v0, f32x4& v1) { v0[0] = bflo(w.x); v0[1] = bfhi(w.x); v0[2] = bflo(w.y); v0[3] = bfhi(w.y); v1[0] = bflo(w.z); v1[1] = bfhi(w.z); v1[2] = bflo(w.w); v1[3] = bfhi(w.w); }
template <bool EMIT8> struct EpiResid {
    static constexpr bool PERM = true, AFTER_DRAIN = false;
    const float* base_f32; bf16_t* xb; unsigned long long* ss_out; float scale; long x8_delta;
    __device__ __forceinline__ void operator()(const f32x4 (&acc)[2][2][4][2], const Unit& u, int wr, int wc, int fr_, int fq_) const {
        const int fr = launder_v(fr_), fq = launder_v(fq_);
        const int row0 = u.pm * BM + wr * 64 + fr, col0 = u.pn * BM + wc * 32 + 8 * fq;
        if (base_f32) {
#pragma unroll
            for (int ai = 0; ai < 2; ++ai)
#pragma unroll
                for (int m = 0; m < 4; ++m) { const int row = row0 + ai * HALF + m * 16; float s = 0.f;
#pragma unroll
                    for (int bj = 0; bj < 2; ++bj) { const size_t off = (size_t)row * 4096 + col0 + bj * HALF;
                        const f32x4 b0 = *(const f32x4*)(base_f32 + off), b1 = *(const f32x4*)(base_f32 + off + 4);
                        const f32x4 v0 = b0 + acc[ai][bj][m][0] * scale, v1 = b1 + acc[ai][bj][m][1] * scale;
                        *(u32x4*)(xb + off) = pack8(v0, v1);
                        if constexpr (EMIT8) { typedef unsigned u32x2 __attribute__((ext_vector_type(2))); u32x2 w8; w8.x = pk4_fp8(v0[0], v0[1], v0[2], v0[3]); w8.y = pk4_fp8(v1[0], v1[1], v1[2], v1[3]); *(u32x2*)((unsigned char*)xb + x8_delta + off) = w8; }
                        s += (v0[0] * v0[0] + v0[1] * v0[1]) + (v0[2] * v0[2] + v0[3] * v0[3]) + (v1[0] * v1[0] + v1[1] * v1[1]) + (v1[2] * v1[2] + v1[3] * v1[3]); }
                    s += xor_lt32<16>(s); s = sum32(s);
                    if (fq == 0) atomicAdd(ss_out + row, (unsigned long long)(s * SS_SCALE + 0.5f));
                    if (m == 3) asm volatile("" ::: "memory"); }
            return;
        }
        u32x4 xr[2][4][2];
#define RES_LD(ai, m) do { _Pragma("unroll") for (int bj = 0; bj < 2; ++bj) xr[ai][m][bj] = *(const u32x4*)(xb + (size_t)(row0 + (ai) * HALF + (m) * 16) * 4096 + col0 + bj * HALF); } while (0)
        RES_LD(0, 0); RES_LD(0, 1); RES_LD(0, 2); RES_LD(0, 3); RES_LD(1, 0); RES_LD(1, 1);
        asm volatile("" ::: "memory");
#pragma unroll
        for (int ai = 0; ai < 2; ++ai)
#pragma unroll
            for (int m = 0; m < 4; ++m) { const int row = row0 + ai * HALF + m * 16; float s = 0.f;
#pragma unroll
                for (int bj = 0; bj < 2; ++bj) { const size_t off = (size_t)row * 4096 + col0 + bj * HALF;
                    f32x4 b0, b1; unpack8(xr[ai][m][bj], b0, b1);
                    const f32x4 v0 = b0 + acc[ai][bj][m][0] * scale, v1 = b1 + acc[ai][bj][m][1] * scale;
                    *(u32x4*)(xb + off) = pack8(v0, v1);
                    if constexpr (EMIT8) { typedef unsigned u32x2 __attribute__((ext_vector_type(2))); u32x2 w8; w8.x = pk4_fp8(v0[0], v0[1], v0[2], v0[3]); w8.y = pk4_fp8(v1[0], v1[1], v1[2], v1[3]); *(u32x2*)((unsigned char*)xb + x8_delta + off) = w8; }
                    s += (v0[0] * v0[0] + v0[1] * v0[1]) + (v0[2] * v0[2] + v0[3] * v0[3]) + (v1[0] * v1[0] + v1[1] * v1[1]) + (v1[2] * v1[2] + v1[3] * v1[3]); }
                s += xor_lt32<16>(s); s = sum32(s);
                if (fq == 0) atomicAdd(ss_out + row, (unsigned long long)(s * SS_SCALE + 0.5f));
                if (ai == 0 && m == 1) { asm volatile("" ::: "memory"); RES_LD(1, 2); RES_LD(1, 3); asm volatile("" ::: "memory"); } }
#undef RES_LD
    }
};
struct EpiQKVG {
    static constexpr bool PERM = true, AFTER_DRAIN = false;
    bf16_t* qkv; bf16_t* gates; const unsigned long long* ss; const float* cosA; const float* sinA; const float* cosC; const float* sinC; RowScales R;
    __device__ __forceinline__ void operator()(const f32x4 (&acc)[2][2][4][2], const Unit& u, int wr, int wc, int fr_, int fq_) const {
        const int fr = launder_v(fr_), fq = launder_v(fq_);
        constexpr size_t MM = 16384;
        const int row0 = u.pm * BM + wr * 64 + fr; const int pn = u.pn;
        bf16_t* const QA = qkv; bf16_t* const KA = QA + MM * 2048; bf16_t* const VA = KA + MM * 512; bf16_t* const QB = VA + MM * 512; bf16_t* const KB = QB + MM * 1024; bf16_t* const VB = KB + MM * 1024;
        bf16_t* const QC = VB + MM * 1024; bf16_t* const KC = QC + MM * 1024; bf16_t* const VC = KC + MM * 1024;
        constexpr float L2E = 1.44269504089f;
        if (pn >= 36) {
            const int col0 = (pn - 36) * BM + wc * 32 + 8 * fq;
#pragma unroll
            for (int ai = 0; ai < 2; ++ai)
#pragma unroll
                for (int m = 0; m < 4; ++m) { const int row = row0 + ai * HALF + m * 16; const float rs = rstd_from(ss, row, RMS_EPS);
#pragma unroll
                    for (int bj = 0; bj < 2; ++bj) { f32x4 v0, v1;
#pragma unroll
                        for (int i = 0; i < 4; ++i) { v0[i] = sigm(acc[ai][bj][m][0][i] * rs); v1[i] = sigm(acc[ai][bj][m][1][i] * rs); }
                        *(u32x4*)(gates + (size_t)row * 12288 + col0 + bj * HALF) = pack8(v0, v1); } }
        } else if (pn < 10 || (pn >= 24 && pn < 32)) {
            const bool isA = pn < 10;
            bf16_t* dst; int ld, hcol, idx0, half; const float* ct; const float* st; float sc;
            if (isA) { const bool q = pn < 8; const int t = q ? pn : pn - 8; dst = q ? QA : KA; ld = q ? 2048 : 512; hcol = (2 * t + (wc >> 1)) * 128; idx0 = 32 * (wc & 1) + 8 * fq; half = 64; ct = cosA; st = sinA; sc = q ? 0.08838834764831845f * L2E : 1.0f; }
            else { const bool q = pn < 28; const int t = (pn - 24) & 3; dst = q ? QC : KC; ld = 1024; hcol = (4 * t + wc) * 64; idx0 = 8 * fq; half = 32; ct = cosC; st = sinC; sc = q ? 0.125f * L2E : 1.0f; }
#pragma unroll
            for (int ai = 0; ai < 2; ++ai)
#pragma unroll
                for (int m = 0; m < 4; ++m) { const int row = row0 + ai * HALF + m * 16; const float rs = R.get(ss, u, ai, m, row, 1.0f); const int pos = row & 4095;
                    const float* cp = ct + (size_t)pos * half + idx0; const float* sp = st + (size_t)pos * half + idx0;
                    const float k = rs * sc;
                    const f32x4 c0 = *(const f32x4*)cp * k, c1 = *(const f32x4*)(cp + 4) * k, s0 = *(const f32x4*)sp * k, s1 = *(const f32x4*)(sp + 4) * k;
                    const f32x4 a0 = acc[ai][0][m][0], a1 = acc[ai][0][m][1], b0 = acc[ai][1][m][0], b1 = acc[ai][1][m][1];
                    const f32x4 y10 = a0 * c0 - b0 * s0, y11 = a1 * c1 - b1 * s1, y20 = b0 * c0 + a0 * s0, y21 = b1 * c1 + a1 * s1;
                    bf16_t* rp = dst + (size_t)row * ld + hcol + idx0;
                    *(u32x4*)rp = pack8(y10, y11); *(u32x4*)(rp + half) = pack8(y20, y21); }
        } else {
            bf16_t* dst; int ld, t0; float sc = 1.0f;
            if (pn < 12) { dst = VA; ld = 512; t0 = 10; } else if (pn < 16) { dst = QB; ld = 1024; t0 = 12; sc = 0.08838834764831845f * L2E; } else if (pn < 20) { dst = KB; ld = 1024; t0 = 16; }
            else if (pn < 24) { dst = VB; ld = 1024; t0 = 20; } else { dst = VC; ld = 1024; t0 = 32; }
            const int col0 = (pn - t0) * BM + wc * 32 + 8 * fq;
#pragma unroll
            for (int ai = 0; ai < 2; ++ai)
#pragma unroll
                for (int m = 0; m < 4; ++m) { const int row = row0 + ai * HALF + m * 16; const float rs = R.get(ss, u, ai, m, row, 1.0f) * sc;
#pragma unroll
                    for (int bj = 0; bj < 2; ++bj) *(u32x4*)(dst + (size_t)row * ld + col0 + bj * HALF) = pack8(acc[ai][bj][m][0] * rs, acc[ai][bj][m][1] * rs); }
        }
    }
};
struct EpiGates {
    static constexpr bool PERM = true, AFTER_DRAIN = false;
    unsigned char* gates; const unsigned long long* ss; RowScales R;
    __device__ __forceinline__ void operator()(const f32x4 (&acc)[2][2][4][2], const Unit& u, int wr, int wc, int fr_, int fq_) const {
        const int fr = launder_v(fr_), fq = launder_v(fq_);
        const int row0 = u.pm * BM + wr * 64 + fr;
        u32x4* rec = (u32x4*)gates + ((size_t)(u.pm * 48 + u.pn) * 8 + (wr * 4 + wc)) * 8 * 64 + (fq * 16 + fr);
#pragma unroll
        for (int ai = 0; ai < 2; ++ai)
#pragma unroll
            for (int m = 0; m < 4; ++m) { const int row = row0 + ai * HALF + m * 16; const float rs = R.get(ss, u, ai, m, row, 1.0f / 64.0f) * -1.44269504089f;
                u32x4 w;
#pragma unroll
                for (int bj = 0; bj < 2; ++bj) { unsigned q[8];
#pragma unroll
                    for (int i = 0; i < 4; ++i) {
                        q[i] = __float_as_uint(__builtin_amdgcn_rcpf(__builtin_amdgcn_fmed3f(__builtin_fmaf(__builtin_amdgcn_exp2f(acc[ai][bj][m][0][i] * rs), 1.0f / 255.0f, 1.0f / 255.0f), 0.0f, 1.0f)) + 8388608.0f);
                        q[4 + i] = __float_as_uint(__builtin_amdgcn_rcpf(__builtin_amdgcn_fmed3f(__builtin_fmaf(__builtin_amdgcn_exp2f(acc[ai][bj][m][1][i] * rs), 1.0f / 255.0f, 1.0f / 255.0f), 0.0f, 1.0f)) + 8388608.0f); }
                    const unsigned lo = __builtin_amdgcn_perm(q[1], q[0], 0x0c0c0400u) | __builtin_amdgcn_perm(q[3], q[2], 0x04000c0cu), hi = __builtin_amdgcn_perm(q[5], q[4], 0x0c0c0400u) | __builtin_amdgcn_perm(q[7], q[6], 0x04000c0cu);
                    if (bj == 0) { w.x = lo; w.y = hi; } else { w.z = lo; w.w = hi; } }
                rec[(ai * 4 + m) * 64] = w; }
    }
};
struct EpiMerge {
    static constexpr bool PERM = true, AFTER_DRAIN = false;
    const unsigned char* gates; bf16_t* mb; int mode;
    __device__ __forceinline__ void operator()(const f32x4 (&acc)[2][2][4][2], const Unit& u, int wr, int wc, int fr_, int fq_) const {
        const int fr = launder_v(fr_), fq = launder_v(fq_);
        const int row0 = u.pm * BM + wr * 64 + fr, col0 = u.pn * BM + wc * 32 + 8 * fq;
#pragma unroll
        for (int ai = 0; ai < 2; ++ai)
#pragma unroll
            for (int m = 0; m < 4; ++m) { const int row = row0 + ai * HALF + m * 16;
#pragma unroll
                for (int bj = 0; bj < 2; ++bj) { const size_t off = (size_t)row * 4096 + col0 + bj * HALF;
                    typedef unsigned u32x2 __attribute__((ext_vector_type(2))); const u32x2 gw = *(const u32x2*)(gates + (size_t)row * 12288 + col0 + bj * HALF);
                    f32x4 v0, v1; v0[0] = (float)(gw.x & 0xffu); v0[1] = (float)((gw.x >> 8) & 0xffu); v0[2] = (float)((gw.x >> 16) & 0xffu); v0[3] = (float)(gw.x >> 24);
                    v1[0] = (float)(gw.y & 0xffu); v1[1] = (float)((gw.y >> 8) & 0xffu); v1[2] = (float)((gw.y >> 16) & 0xffu); v1[3] = (float)(gw.y >> 24);
                    v0 = v0 * acc[ai][bj][m][0] * (1.0f / 255.0f); v1 = v1 * acc[ai][bj][m][1] * (1.0f / 255.0f);
                    if (mode != 0) { f32x4 p0, p1; unpack8(*(const u32x4*)(mb + off), p0, p1); v0 = v0 + p0; v1 = v1 + p1; }
                    *(u32x4*)(mb + off) = pack8(v0, v1); }
                if (m == 3) asm volatile("" ::: "memory"); }
    }
};

typedef int v8i32 __attribute__((ext_vector_type(8))); typedef int v4i32 __attribute__((ext_vector_type(4)));
__device__ __forceinline__ v8i32 cat8(const bf16x8 lo, const bf16x8 hi) { const v4i32 a = __builtin_bit_cast(v4i32, lo), b = __builtin_bit_cast(v4i32, hi); return __builtin_shufflevector(a, b, 0, 1, 2, 3, 4, 5, 6, 7); }
template <class Epi, class Sched, bool ALIGN_EPI = false, bool SP2 = false, bool FP8 = false>
__device__ __forceinline__ void gemm_phase(PG8_LAS unsigned char* lds, const Gemm g, const Sched& S, const Epi& E, int wid) {
    const int lane = lane_id(), tid = wid * 64 + lane, wr = wid >> 2, wc = wid & 3, fr = lane & 15, fq = lane >> 4;
    const int K = g.K, nt = K / BK;
    unsigned voffA[2], voffB[2];
#pragma unroll
    for (int i = 0; i < 2; ++i) { int R, C; stage_rc(tid * 16 + i * 8192, R, C); const int Rb = Epi::PERM ? ((R & ~31) + perm32(R & 31)) : R;
        voffA[i] = (unsigned)(R * K + C) * 2u; voffB[i] = (unsigned)(Rb * K + C) * 2u; }
    const size_t kstep = (size_t)(BK * 2);
    const size_t hstep = (size_t)HALF * K * 2;
    const size_t tstep = 2 * hstep;
    const unsigned ldsw = (unsigned)wid * 1024u;
    const int aoff = lds_byte(wr * 64 + fr, fq * 8), boff = lds_byte(wc * 32 + fr, fq * 8);
#define PG8_SA(b, h) (((b) * 2 + (h)) * HTB)
#define PG8_SB(b, h) ((4 + (b) * 2 + (h)) * HTB)
#define PG8_STAGE(bufoff, gbase, voff) do { _Pragma("unroll") for (int _i = 0; _i < 2; ++_i) \
        __builtin_amdgcn_global_load_lds((const unsigned*)((const char*)(gbase) + (voff)[_i]), (PG8_LAS unsigned*)(lds + (bufoff) + ldsw + _i * 8192), 16, 0, 0); } while (0)
#define PG8_LDA(dst, b, h) do { _Pragma("unroll") for (int m = 0; m < 4; ++m) _Pragma("unroll") for (int k = 0; k < 2; ++k) dst[m][k] = *(const PG8_LAS bf16x8*)(lds + PG8_SA(b, h) + aoff + m * 2048 + k * 1024); } while (0)
#define PG8_LDB(dst, b, h) do { _Pragma("unroll") for (int n = 0; n < 2; ++n) _Pragma("unroll") for (int k = 0; k < 2; ++k) dst[n][k] = *(const PG8_LAS bf16x8*)(lds + PG8_SB(b, h) + boff + n * 2048 + k * 1024); } while (0)
#define PG8_MMA(ai, bj, At, Bt) do { __builtin_amdgcn_s_setprio(1); _Pragma("unroll") for (int m = 0; m < 4; ++m) _Pragma("unroll") for (int n = 0; n < 2; ++n) { \
        if constexpr (FP8) { asm volatile("s_nop 1\n\tv_mfma_scale_f32_16x16x128_f8f6f4 %0, %1, %2, %0, %3, %3 op_sel_hi:[0,0,0]" : "+v"(acc[ai][bj][m][n]) : "v"(cat8(Bt[n][0], Bt[n][1])), "v"(cat8(At[m][0], At[m][1])), "v"(0x7f7f7f7f)); } \
        else { _Pragma("unroll") for (int k = 0; k < 2; ++k) acc[ai][bj][m][n] = __builtin_amdgcn_mfma_f32_16x16x32_bf16(Bt[n][k], At[m][k], acc[ai][bj][m][n], 0, 0, 0); } } __builtin_amdgcn_s_setprio(0); } while (0)
#define PG8_WAIT_V(n) asm volatile("s_waitcnt vmcnt(" #n ")" ::: "memory")
#define PG8_WAIT_L(n) asm volatile("s_waitcnt lgkmcnt(" #n ")" ::: "memory")
#define PG8_BAR __builtin_amdgcn_s_barrier()
#define PG8_SCHED __builtin_amdgcn_sched_barrier(0)
    Unit cur, nxt; int ui = 0;
    if (!S.next(0, cur)) return;
    f32x4 acc[2][2][4][2];
#pragma unroll
    for (int a = 0; a < 2; ++a)
#pragma unroll
        for (int b = 0; b < 2; ++b)
#pragma unroll
            for (int m = 0; m < 4; ++m)
#pragma unroll
                for (int n = 0; n < 2; ++n) acc[a][b][m][n] = (f32x4){0.f, 0.f, 0.f, 0.f};
    bf16x8 At[4][2], B0[2][2], B1[2][2];
    const char* cA = (const char*)g.A + (size_t)cur.pm * tstep; const char* cB = (const char*)g.Bt + (size_t)cur.pn * tstep;
    S.a_ready(cur);
    if constexpr (SP2) {
        PG8_STAGE(PG8_SB(0, 0), cB, voffB); PG8_STAGE(PG8_SB(0, 1), cB + hstep, voffB); PG8_STAGE(PG8_SA(0, 0), cA, voffA); PG8_STAGE(PG8_SA(0, 1), cA + hstep, voffA);
        if (wr == 1) PG8_BAR;
        PG8_WAIT_V(2); PG8_BAR;
        PG8_STAGE(PG8_SB(1, 0), cB + kstep, voffB); PG8_STAGE(PG8_SA(1, 0), cA + kstep, voffA); PG8_STAGE(PG8_SB(1, 1), cB + hstep + kstep, voffB);
        PG8_WAIT_V(6); PG8_BAR;
    } else {
        PG8_STAGE(PG8_SB(0, 0), cB, voffB); PG8_STAGE(PG8_SA(0, 0), cA, voffA); PG8_STAGE(PG8_SB(0, 1), cB + hstep, voffB); PG8_STAGE(PG8_SA(0, 1), cA + hstep, voffA);
        if (wr == 1) PG8_BAR;
        PG8_WAIT_V(4); PG8_BAR;
        PG8_STAGE(PG8_SB(1, 0), cB + kstep, voffB); PG8_STAGE(PG8_SA(1, 0), cA + kstep, voffA); PG8_STAGE(PG8_SB(1, 1), cB + hstep + kstep, voffB);
        PG8_WAIT_V(6); PG8_BAR;
    }
    for (;;) {
        const bool has_next = S.next(ui + 1, nxt);
        const char* nA = has_next ? (const char*)g.A + (size_t)nxt.pm * tstep : cA; const char* nB = has_next ? (const char*)g.Bt + (size_t)nxt.pn * tstep : cB;
        for (int t = 0; t < nt; t += 2) {
            const bool last = (t == nt - 2);
            const char* a1 = cA + (size_t)(t + 1) * kstep;
            const char* a2 = last ? nA : cA + (size_t)(t + 2) * kstep; const char* b2 = last ? nB : cB + (size_t)(t + 2) * kstep;
            const char* a3 = a2 + kstep; const char* b3 = b2 + kstep;
            if (last && has_next) S.a_ready(nxt);
            if constexpr (SP2) {
            PG8_LDB(B0, 0, 0); PG8_LDB(B1, 0, 1); PG8_SCHED; PG8_LDA(At, 0, 0); PG8_STAGE(PG8_SA(1, 1), a1 + hstep, voffA);
            PG8_WAIT_V(8); PG8_WAIT_L(0); PG8_BAR; PG8_MMA(0, 0, At, B0); PG8_MMA(0, 1, At, B1); PG8_BAR; PG8_SCHED;
            PG8_LDA(At, 0, 1); PG8_STAGE(PG8_SB(0, 0), b2, voffB); PG8_STAGE(PG8_SB(0, 1), b2 + hstep, voffB); PG8_STAGE(PG8_SA(0, 0), a2, voffA);
            PG8_WAIT_V(8); PG8_WAIT_L(0); PG8_BAR; PG8_MMA(1, 0, At, B0); PG8_MMA(1, 1, At, B1); PG8_BAR; PG8_SCHED;
            PG8_LDB(B0, 1, 0); PG8_LDB(B1, 1, 1); PG8_SCHED; PG8_LDA(At, 1, 0); PG8_STAGE(PG8_SA(0, 1), a2 + hstep, voffA);
            PG8_WAIT_V(8); PG8_WAIT_L(0); PG8_BAR; PG8_MMA(0, 0, At, B0); PG8_MMA(0, 1, At, B1); PG8_BAR; PG8_SCHED;
            PG8_LDA(At, 1, 1); PG8_STAGE(PG8_SB(1, 0), b3, voffB); PG8_STAGE(PG8_SB(1, 1), b3 + hstep, voffB); PG8_STAGE(PG8_SA(1, 0), a3, voffA);
            PG8_WAIT_V(8); PG8_WAIT_L(0); PG8_BAR; PG8_MMA(1, 0, At, B0); PG8_MMA(1, 1, At, B1); PG8_BAR; PG8_SCHED;
            } else {
            PG8_LDB(B0, 0, 0); PG8_SCHED; PG8_LDA(At, 0, 0); PG8_STAGE(PG8_SA(1, 1), a1 + hstep, voffA);
            PG8_WAIT_L(8); PG8_BAR; PG8_WAIT_L(0); PG8_MMA(0, 0, At, B0); PG8_BAR; PG8_SCHED;
            PG8_LDB(B1, 0, 1); PG8_STAGE(PG8_SB(0, 0), b2, voffB);
            PG8_BAR; PG8_WAIT_L(0); PG8_MMA(0, 1, At, B1); PG8_BAR;
            PG8_LDA(At, 0, 1); PG8_STAGE(PG8_SA(0, 0), a2, voffA);
            PG8_BAR; PG8_WAIT_L(0); PG8_MMA(1, 0, At, B0); PG8_BAR; PG8_SCHED;
            PG8_STAGE(PG8_SB(0, 1), b2 + hstep, voffB);
            PG8_WAIT_V(6); PG8_BAR; PG8_MMA(1, 1, At, B1); PG8_BAR;
            PG8_LDB(B0, 1, 0); PG8_SCHED; PG8_LDA(At, 1, 0); PG8_STAGE(PG8_SA(0, 1), a2 + hstep, voffA);
            PG8_WAIT_L(8); PG8_BAR; PG8_WAIT_L(0); PG8_MMA(0, 0, At, B0); PG8_BAR; PG8_SCHED;
            PG8_LDB(B1, 1, 1); PG8_STAGE(PG8_SB(1, 0), b3, voffB);
            PG8_BAR; PG8_WAIT_L(0); PG8_MMA(0, 1, At, B1); PG8_BAR;
            PG8_LDA(At, 1, 1); PG8_STAGE(PG8_SA(1, 0), a3, voffA);
            PG8_BAR; PG8_WAIT_L(0); PG8_MMA(1, 0, At, B0); PG8_BAR; PG8_SCHED;
            PG8_STAGE(PG8_SB(1, 1), b3 + hstep, voffB);
            PG8_WAIT_V(6); PG8_BAR; PG8_MMA(1, 1, At, B1); PG8_BAR;
            }
        }
        if constexpr (ALIGN_EPI) { if (wr == 0) PG8_BAR; }
        if constexpr (FP8) asm volatile("s_nop 15\n\ts_nop 15" ::: "memory");
        if constexpr (!Epi::AFTER_DRAIN) { E(acc, cur, wr, wc, fr, fq); S.done(cur); }
        if (!has_next) break;
#pragma unroll
        for (int a = 0; a < 2; ++a)
#pragma unroll
            for (int b = 0; b < 2; ++b)
#pragma unroll
                for (int m = 0; m < 4; ++m)
#pragma unroll
                    for (int n = 0; n < 2; ++n) acc[a][b][m][n] = (f32x4){0.f, 0.f, 0.f, 0.f};
        cur = nxt; cA = nA; cB = nB; ++ui;
        if constexpr (ALIGN_EPI) { if (wr == 1) PG8_BAR; }
    }
    PG8_WAIT_V(0);
    if constexpr (!ALIGN_EPI) { if (wr == 0) PG8_BAR; }
    PG8_BAR;
#undef PG8_SA
#undef PG8_SB
#undef PG8_STAGE
#undef PG8_LDA
#undef PG8_LDB
#undef PG8_MMA
#undef PG8_WAIT_V
#undef PG8_WAIT_L
#undef PG8_BAR
#undef PG8_SCHED
}

struct MergeGemm { const bf16_t* Aa; const bf16_t* Abc; const bf16_t* Ba; const bf16_t* Bbc; const unsigned char* gates; bf16_t* mb; };
__device__ __forceinline__ void unpack_u8(const unsigned w, float (&f)[4]) { f[0] = (float)(w & 0xffu); f[1] = (float)((w >> 8) & 0xffu); f[2] = (float)((w >> 16) & 0xffu); f[3] = (float)(w >> 24); }
template <class Sched>
__device__ __forceinline__ void gemm_phase_merge(PG8_LAS unsigned char* lds, const MergeGemm g, const Sched& S, int wid) {
    constexpr int K = 2048;
    const int lane = lane_id(), tid = wid * 64 + lane, wr = wid >> 2, wc = wid & 3, fr = lane & 15, fq = lane >> 4;
    unsigned voffA[2], voffB[2];
#pragma unroll
    for (int i = 0; i < 2; ++i) { int R, C; stage_rc(tid * 16 + i * 8192, R, C); const int Rb = (R & ~31) + perm32(R & 31);
        voffA[i] = (unsigned)(R * K + C) * 2u; voffB[i] = (unsigned)(Rb * K + C) * 2u; }
    const size_t kstep = (size_t)(BK * 2);
    const size_t hstep = (size_t)HALF * K * 2;
    const size_t tstep = 2 * hstep;
    const unsigned ldsw = (unsigned)wid * 1024u;
    const int aoff = lds_byte(wr * 64 + fr, fq * 8), boff = lds_byte(wc * 32 + fr, fq * 8);
#define PG8_SA(b, h) (((b) * 2 + (h)) * HTB)
#define PG8_SB(b, h) ((4 + (b) * 2 + (h)) * HTB)
#define PG8_STAGE(bufoff, gbase, voff) do { _Pragma("unroll") for (int _i = 0; _i < 2; ++_i) \
        __builtin_amdgcn_global_load_lds((const unsigned*)((const char*)(gbase) + (voff)[_i]), (PG8_LAS unsigned*)(lds + (bufoff) + ldsw + _i * 8192), 16, 0, 0); } while (0)
#define PG8_LDA(dst, b, h) do { _Pragma("unroll") for (int m = 0; m < 4; ++m) _Pragma("unroll") for (int k = 0; k < 2; ++k) dst[m][k] = *(const PG8_LAS bf16x8*)(lds + PG8_SA(b, h) + aoff + m * 2048 + k * 1024); } while (0)
#define PG8_LDB(dst, b, h) do { _Pragma("unroll") for (int n = 0; n < 2; ++n) _Pragma("unroll") for (int k = 0; k < 2; ++k) dst[n][k] = *(const PG8_LAS bf16x8*)(lds + PG8_SB(b, h) + boff + n * 2048 + k * 1024); } while (0)
#define PG8_MMA(ai, bj, At, Bt) do { __builtin_amdgcn_s_setprio(1); _Pragma("unroll") for (int m = 0; m < 4; ++m) _Pragma("unroll") for (int n = 0; n < 2; ++n) _Pragma("unroll") for (int k = 0; k < 2; ++k) \
        acc[ai][bj][m][n] = __builtin_amdgcn_mfma_f32_16x16x32_bf16(Bt[n][k], At[m][k], acc[ai][bj][m][n], 0, 0, 0); __builtin_amdgcn_s_setprio(0); } while (0)
#define PG8_WAIT_V(n) asm volatile("s_waitcnt vmcnt(" #n ")" ::: "memory")
#define PG8_WAIT_L(n) asm volatile("s_waitcnt lgkmcnt(" #n ")" ::: "memory")
#define PG8_BAR __builtin_amdgcn_s_barrier()
#define PG8_SCHED __builtin_amdgcn_sched_barrier(0)
#define MG_A(pm, br) ((const char*)((br) == 0 ? g.Aa : g.Abc + ((br) == 2 ? 1024 : 0)) + (size_t)(pm) * tstep)
#define MG_B(pn, br) ((const char*)((br) == 0 ? g.Ba : g.Bbc + ((br) == 2 ? 1024 : 0)) + (size_t)(pn) * tstep)
    Unit cur, nu; int ui = 0, br = 0;
    if (!S.next(0, cur)) return;
    f32x4 acc[2][2][4][2];
#pragma unroll
    for (int a = 0; a < 2; ++a)
#pragma unroll
        for (int b = 0; b < 2; ++b)
#pragma unroll
            for (int m = 0; m < 4; ++m)
#pragma unroll
                for (int n = 0; n < 2; ++n) acc[a][b][m][n] = (f32x4){0.f, 0.f, 0.f, 0.f};
    bf16x8 At[4][2], B0[2][2], B1[2][2];
    const char* cA = MG_A(cur.pm, 0); const char* cB = MG_B(cur.pn, 0);
    PG8_STAGE(PG8_SB(0, 0), cB, voffB); PG8_STAGE(PG8_SB(0, 1), cB + hstep, voffB); PG8_STAGE(PG8_SA(0, 0), cA, voffA); PG8_STAGE(PG8_SA(0, 1), cA + hstep, voffA);
    if (wr == 1) PG8_BAR;
    PG8_WAIT_V(2); PG8_BAR;
    PG8_STAGE(PG8_SB(1, 0), cB + kstep, voffB); PG8_STAGE(PG8_SA(1, 0), cA + kstep, voffA); PG8_STAGE(PG8_SB(1, 1), cB + hstep + kstep, voffB);
    PG8_WAIT_V(6); PG8_BAR;
    for (;;) {
        int nbr = br + 1; bool has_next = true; nu = cur;
        if (nbr == 3) { nbr = 0; has_next = S.next(ui + 1, nu); }
        const char* nA = has_next ? MG_A(nu.pm, nbr) : cA; const char* nB = has_next ? MG_B(nu.pn, nbr) : cB;
        const int nt = br == 0 ? 32 : 16;
        for (int t = 0; t < nt; t += 2) {
            const bool last = (t == nt - 2);
            const char* a1 = cA + (size_t)(t + 1) * kstep;
            const char* a2 = last ? nA : cA + (size_t)(t + 2) * kstep; const char* b2 = last ? nB : cB + (size_t)(t + 2) * kstep;
            const char* a3 = a2 + kstep; const char* b3 = b2 + kstep;
            PG8_LDB(B0, 0, 0); PG8_LDB(B1, 0, 1); PG8_SCHED; PG8_LDA(At, 0, 0); PG8_STAGE(PG8_SA(1, 1), a1 + hstep, voffA);
            PG8_WAIT_V(8); PG8_WAIT_L(0); PG8_BAR; PG8_MMA(0, 0, At, B0); PG8_MMA(0, 1, At, B1); PG8_BAR; PG8_SCHED;
            PG8_LDA(At, 0, 1); PG8_STAGE(PG8_SB(0, 0), b2, voffB); PG8_STAGE(PG8_SB(0, 1), b2 + hstep, voffB); PG8_STAGE(PG8_SA(0, 0), a2, voffA);
            PG8_WAIT_V(8); PG8_WAIT_L(0); PG8_BAR; PG8_MMA(1, 0, At, B0); PG8_MMA(1, 1, At, B1); PG8_BAR; PG8_SCHED;
            PG8_LDB(B0, 1, 0); PG8_LDB(B1, 1, 1); PG8_SCHED; PG8_LDA(At, 1, 0); PG8_STAGE(PG8_SA(0, 1), a2 + hstep, voffA);
            PG8_WAIT_V(8); PG8_WAIT_L(0); PG8_BAR; PG8_MMA(0, 0, At, B0); PG8_MMA(0, 1, At, B1); PG8_BAR; PG8_SCHED;
            PG8_LDA(At, 1, 1); PG8_STAGE(PG8_SB(1, 0), b3, voffB); PG8_STAGE(PG8_SB(1, 1), b3 + hstep, voffB); PG8_STAGE(PG8_SA(1, 0), a3, voffA);
            PG8_WAIT_V(8); PG8_WAIT_L(0); PG8_BAR; PG8_MMA(1, 0, At, B0); PG8_MMA(1, 1, At, B1); PG8_BAR; PG8_SCHED;
        }
        if (wr == 0) PG8_BAR;
        {
            const int fr2 = launder_v(fr), fq2 = launder_v(fq);
            const int row0 = cur.pm * BM + wr * 64 + fr2, col0 = cur.pn * BM + wc * 32 + 8 * fq2;
            const u32x4* rec = (const u32x4*)g.gates + ((size_t)(cur.pm * 48 + br * 16 + cur.pn) * 8 + wid) * 8 * 64 + (fq2 * 16 + fr2);
#pragma unroll
            for (int ai = 0; ai < 2; ++ai)
#pragma unroll
                for (int m = 0; m < 4; ++m) { const int row = row0 + ai * HALF + m * 16;
                    const u32x4 gc = rec[(ai * 4 + m) * 64];
                    if (br < 2) {
                        const u32x4 gn = rec[(size_t)16 * 8 * 8 * 64 + (ai * 4 + m) * 64];
#pragma unroll
                        for (int bj = 0; bj < 2; ++bj) { float c0[4], c1[4], n0[4], n1[4]; unpack_u8(bj ? gc.z : gc.x, c0); unpack_u8(bj ? gc.w : gc.y, c1); unpack_u8(bj ? gn.z : gn.x, n0); unpack_u8(bj ? gn.w : gn.y, n1);
#pragma unroll
                            for (int i = 0; i < 4; ++i) { acc[ai][bj][m][0][i] *= c0[i] * __builtin_amdgcn_rcpf(n0[i]); acc[ai][bj][m][1][i] *= c1[i] * __builtin_amdgcn_rcpf(n1[i]); } }
                    } else {
#pragma unroll
                        for (int bj = 0; bj < 2; ++bj) { float c0[4], c1[4]; unpack_u8(bj ? gc.z : gc.x, c0); unpack_u8(bj ? gc.w : gc.y, c1);
                            f32x4 v0, v1;
#pragma unroll
                            for (int i = 0; i < 4; ++i) { v0[i] = acc[ai][bj][m][0][i] * c0[i]; v1[i] = acc[ai][bj][m][1][i] * c1[i]; }
                            *(u32x4*)(g.mb + (size_t)row * 4096 + col0 + bj * HALF) = pack8(v0, v1); } }
                    if (m == 3) asm volatile("" ::: "memory"); }
        }
        if (!has_next) break;
        if (br == 2) {
#pragma unroll
            for (int a = 0; a < 2; ++a)
#pragma unroll
                for (int b = 0; b < 2; ++b)
#pragma unroll
                    for (int m = 0; m < 4; ++m)
#pragma unroll
                        for (int n = 0; n < 2; ++n) acc[a][b][m][n] = (f32x4){0.f, 0.f, 0.f, 0.f};
            ++ui; }
        cur = nu; br = nbr; cA = nA; cB = nB;
        if (wr == 1) PG8_BAR;
    }
    PG8_WAIT_V(0);
    PG8_BAR;
#undef MG_A
#undef MG_B
#undef PG8_SA
#undef PG8_SB
#undef PG8_STAGE
#undef PG8_LDA
#undef PG8_LDB
#undef PG8_MMA
#undef PG8_WAIT_V
#undef PG8_WAIT_L
#undef PG8_BAR
#undef PG8_SCHED
}
}

constexpr int NWAVES = 8;
constexpr int DM = 4096, SEQ = 4096, NBATCH = 4, DEPTH = 4, DFF = 4096;
constexpr int M = NBATCH * SEQ;
constexpr int NQKV = 9216, NGATE = 12288, NQG = NQKV + NGATE;
constexpr int NPH = 2 + 8 * DEPTH;

constexpr size_t MiB = 1u << 20;
constexpr size_t WS_CTL = 0, CTL_ZERO_BYTES = 4 * MiB;
constexpr int CW_TICKET = 8192;
constexpr int CW_BAR = 16384;
constexpr size_t WS_SS = 1 * MiB;
constexpr size_t WS_ROPE = 4 * MiB;
constexpr size_t WS_W = 8 * MiB, W_LAYER = 424 * MiB;
constexpr size_t WO_W1 = 0, WO_W2 = 64 * MiB, WO_QG = 96 * MiB, WO_A = 264 * MiB, WO_B = 280 * MiB, WO_C = 288 * MiB, WO_O = 296 * MiB, WO_W3 = 328 * MiB, WO_W4 = 392 * MiB;
constexpr size_t WS_XF = WS_W + 4 * W_LAYER;
constexpr size_t WS_WG8 = WS_XF, WG8_LAYER = 48 * MiB;
constexpr size_t WS_XB8 = WS_XF + 192 * MiB;
constexpr size_t WS_XB = WS_XF + 256 * MiB;
constexpr size_t WS_HID = WS_XB + 128 * MiB;
constexpr size_t WS_QKV = WS_HID + 128 * MiB;
constexpr size_t WS_GATES = WS_QKV + 288 * MiB;
constexpr size_t WS_OA = WS_GATES + 384 * MiB;
constexpr size_t WS_MERGED = WS_OA + 128 * MiB, WS_W3F8 = WS_MERGED, WS_W4F8 = WS_MERGED + 32 * MiB;
#define FFN2_FP8(l) ((l) == 3)
constexpr size_t WS_MB = WS_MERGED + 256 * MiB;
constexpr size_t WS_END = WS_MB + 128 * MiB;

constexpr int RING_OFF = 0, RING_BYTES = 131072;
constexpr int LDSCTL_OFF = RING_BYTES, MISC_OFF = LDSCTL_OFF + 320;
constexpr int LDS_BYTES = 147456;
static_assert(MISC_OFF + 128 <= LDS_BYTES, "LDS map");

#define GAS __attribute__((address_space(1)))
#define LAS __attribute__((address_space(3)))
typedef unsigned short bf16;
typedef unsigned v4u __attribute__((ext_vector_type(4)));
typedef float f32x4 __attribute__((ext_vector_type(4)));
typedef GAS unsigned gu32;
#define RLX_AGENT __ATOMIC_RELAXED, __HIP_MEMORY_SCOPE_AGENT
#define LDS_WAIT() asm volatile("s_waitcnt lgkmcnt(0)" ::: "memory")
#define VM_WAIT() asm volatile("s_waitcnt vmcnt(0)" ::: "memory")
__device__ __forceinline__ unsigned f2bf(float f) { unsigned u = __builtin_bit_cast(unsigned, f); return (u + 0x7fffu + ((u >> 16) & 1u)) >> 16; }
__device__ __forceinline__ unsigned pk2(float lo, float hi) { return f2bf(lo) | (f2bf(hi) << 16); }
__device__ __forceinline__ float bf_lo(unsigned w) { return __uint_as_float(w << 16); }
__device__ __forceinline__ float bf_hi(unsigned w) { return __uint_as_float(w & 0xffff0000u); }

#define XB_TMO      128
#define XB_XCNT(j)  (256  + 64 * (j))
#define XB_XSUB(j)  (1280 + 64 * (j))
#define XB_XGEN(j)  (2304 + 64 * (j))
#define XB_TOP      3328
#define XB_TOPGEN   3392
#define XCD_BAR_WORDS 3456
#define XB_SPIN_CAP (1u << 22)

__device__ __forceinline__ unsigned xb_ld(unsigned* p)              { return __hip_atomic_load(p, __ATOMIC_RELAXED, __HIP_MEMORY_SCOPE_AGENT); }
__device__ __forceinline__ unsigned xb_add(unsigned* p, unsigned v) { return __hip_atomic_fetch_add(p, v, __ATOMIC_RELAXED, __HIP_MEMORY_SCOPE_AGENT); }
__device__ __forceinline__ unsigned xb_xcc_id() { return (unsigned)__builtin_amdgcn_readfirstlane((int)((unsigned)__builtin_amdgcn_s_getreg((3 << 11) | 20) & 0xFu)); }
#define XB_SPIN(cond, bar) do { unsigned _sp = 0; while (cond) { __builtin_amdgcn_s_sleep(1); \
    if ((++_sp & 255u) == 0u) { if (xb_ld(&(bar)[XB_TMO])) break; if (_sp > XB_SPIN_CAP) { atomicAdd(&(bar)[XB_TMO], 1u); break; } } } } while (0)

struct XcdBarrier {
    unsigned* bar; unsigned x;
    volatile LAS unsigned* st;
};
__device__ __forceinline__ XcdBarrier xcd_barrier_post(unsigned* bar, volatile LAS unsigned* st) {
    XcdBarrier b; b.bar = bar; b.x = xb_xcc_id(); b.st = st;
    if (threadIdx.x == 0) (void)xb_add(&bar[XB_XCNT(b.x)], 1u);
    return b;
}
__device__ __forceinline__ void xcd_barrier_complete(unsigned* bar, unsigned x, unsigned& nloc, unsigned& nx) {
    const unsigned G = gridDim.x * gridDim.y * gridDim.z;
    unsigned sum, cnt, mine, sp = 0u;
    for (;;) {
        sum = 0u; cnt = 0u; mine = 0u;
#pragma unroll
        for (unsigned j = 0; j < 16; ++j) { const unsigned c = xb_ld(&bar[XB_XCNT(j)]); sum += c; cnt += (c > 0u) ? 1u : 0u; mine = (j == x) ? c : mine; }
        if (sum == G) break;
        __builtin_amdgcn_s_sleep(1);
        if ((++sp & 255u) == 0u) { if (xb_ld(&bar[XB_TMO])) break; if (sp > XB_SPIN_CAP) { atomicAdd(&bar[XB_TMO], 1u); break; } }
    }
    nloc = mine > 0u ? mine : 1u; nx = cnt > 0u ? cnt : 1u;
}
__device__ __forceinline__ void xcd_barrier(const XcdBarrier& b, int wave) {
    asm volatile("s_waitcnt vmcnt(0)" ::: "memory");
    __syncthreads();
    if (wave == 0 && pg8::lane_id() == 0) {
        unsigned* bar = b.bar; unsigned bx = b.x; asm volatile("" : "+s"(bx));
        __builtin_amdgcn_s_waitcnt(0);
        unsigned nloc = b.st[0], nx = b.st[1];
        if (nloc == 0u) { xcd_barrier_complete(bar, bx, nloc, nx); b.st[0] = nloc; b.st[1] = nx; }
        const unsigned old = xb_add(&bar[XB_XSUB(bx)], 1u);
        const unsigned gen = old / nloc;
        if (old + 1u == (gen + 1u) * nloc) {
            __builtin_amdgcn_fence(__ATOMIC_RELEASE, "agent");
            asm volatile("s_waitcnt vmcnt(0)" ::: "memory");
            const unsigned og = xb_add(&bar[XB_TOP], 1u);
            const unsigned tg = og / nx;
            if (og + 1u == (tg + 1u) * nx) xb_add(&bar[XB_TOPGEN], 1u);
            else XB_SPIN(xb_ld(&bar[XB_TOPGEN]) == tg, bar);
            __builtin_amdgcn_fence(__ATOMIC_ACQUIRE, "agent");
            xb_add(&bar[XB_XGEN(bx)], 1u);
            asm volatile("s_waitcnt vmcnt(0)" ::: "memory");
        } else {
            XB_SPIN(xb_ld(&bar[XB_XGEN(bx)]) == gen, bar);
            __builtin_amdgcn_fence(__ATOMIC_ACQUIRE, "agent");
            asm volatile("s_waitcnt vmcnt(0)" ::: "memory");
        }
    }
    __syncthreads();
}

struct Args { const float* in[21]; float* out; unsigned char* ws; int ph_lo, ph_hi, li, pad; };
struct Frame {
    LAS unsigned char* lds;
    volatile LAS unsigned* MISC;
    gu32* ctl;
    int wave;
    int vcu, G;
    int cid;
    unsigned char* ws;
    float* out;
};
__device__ __forceinline__ const float* inp(int i) {
    unsigned off = (unsigned)i * 8u; asm volatile("" : "+s"(off));
    const __attribute__((address_space(4))) char* ka = (const __attribute__((address_space(4))) char*)__builtin_amdgcn_kernarg_segment_ptr();
    return *(const float* const __attribute__((address_space(4)))*)(ka + off);
}
__device__ __forceinline__ unsigned char* launder_p(unsigned char* p) { asm volatile("" : "+s"(p)); return p; }
__device__ __forceinline__ int launder_i(int x) { asm volatile("" : "+s"(x)); return x; }
__device__ __forceinline__ bf16* wgt(unsigned char* ws, int l, size_t off) { return (bf16*)(ws + WS_W + (size_t)l * W_LAYER + off); }
__device__ __forceinline__ unsigned long long* ssbuf(unsigned char* ws, int idx) { return (unsigned long long*)(ws + WS_SS) + (size_t)idx * M; }

__device__ __forceinline__ float wave_sum(float v) {
    v += pg8::xor_lt32<1>(v); v += pg8::xor_lt32<2>(v); v += pg8::xor_lt32<4>(v); v += pg8::xor_lt32<8>(v); v += pg8::xor_lt32<16>(v); return pg8::sum32(v);
}
__device__ __forceinline__ float wave_max(float v) {
    v = fmaxf(v, pg8::xor_lt32<1>(v)); v = fmaxf(v, pg8::xor_lt32<2>(v)); v = fmaxf(v, pg8::xor_lt32<4>(v)); v = fmaxf(v, pg8::xor_lt32<8>(v)); v = fmaxf(v, pg8::xor_lt32<16>(v)); return pg8::max32(v);
}

__device__ const float kInvFreq[64] = {
    1.000000000e+00f, 8.659643531e-01f, 7.498942018e-01f, 6.493816376e-01f, 5.623413324e-01f, 4.869675338e-01f, 4.216965139e-01f, 3.651741147e-01f, 3.162277639e-01f, 2.738419771e-01f, 2.371373922e-01f, 2.053525001e-01f, 1.778279394e-01f, 1.539926529e-01f, 1.333521456e-01f, 1.154782027e-01f,
    1.000000015e-01f, 8.659642935e-02f, 7.498941571e-02f, 6.493816525e-02f, 5.623412877e-02f, 4.869675264e-02f, 4.216964915e-02f, 3.651741147e-02f, 3.162277862e-02f, 2.738419734e-02f, 2.371373586e-02f, 2.053524926e-02f, 1.778279431e-02f, 1.539926510e-02f, 1.333521493e-02f, 1.154781971e-02f,
    9.999999776e-03f, 8.659643121e-03f, 7.498942316e-03f, 6.493816618e-03f, 5.623413250e-03f, 4.869675264e-03f, 4.216964822e-03f, 3.651741426e-03f, 3.162277862e-03f, 2.738419687e-03f, 2.371373819e-03f, 2.053525066e-03f, 1.778279431e-03f, 1.539926627e-03f, 1.333521446e-03f, 1.154781901e-03f,
    1.000000047e-03f, 8.659643354e-04f, 7.498941850e-04f, 6.493816618e-04f, 5.623413017e-04f, 4.869675031e-04f, 4.216965463e-04f, 3.651741135e-04f, 3.162277862e-04f, 2.738419571e-04f, 2.371373848e-04f, 2.053525241e-04f, 1.778279402e-04f, 1.539926452e-04f, 1.333521504e-04f, 1.154782076e-04f };

__device__ __forceinline__ void conv_item(const float* W, int ldw, int src_col0, int k0, const float* gain, bf16* dst, int K, int dst_row0, LAS float* scr, int lane) {
    const int kq = lane >> 3, n4 = (lane & 7) * 4;
    f32x4 v[8];
#pragma unroll
    for (int i = 0; i < 8; ++i) v[i] = __builtin_nontemporal_load((const GAS f32x4*)(W + (size_t)(k0 + kq + 8 * i) * ldw + src_col0 + n4));
    if (gain) {
#pragma unroll
        for (int i = 0; i < 8; ++i) v[i] = v[i] * gain[k0 + kq + 8 * i];
    }
#pragma unroll
    for (int i = 0; i < 8; ++i) { LAS float* s = scr + (kq + 8 * i) * 33 + n4; s[0] = v[i][0]; s[1] = v[i][1]; s[2] = v[i][2]; s[3] = v[i][3]; }
    LDS_WAIT(); asm volatile("" ::: "memory");
    const int c = lane & 7;
#pragma unroll
    for (int j = 0; j < 4; ++j) { const int n = (lane >> 3) + 8 * j; const LAS float* s = scr + (8 * c) * 33 + n;
        v4u o; o.x = pk2(s[0 * 33], s[1 * 33]); o.y = pk2(s[2 * 33], s[3 * 33]); o.z = pk2(s[4 * 33], s[5 * 33]); o.w = pk2(s[6 * 33], s[7 * 33]);
        __builtin_nontemporal_store(o, (GAS v4u*)(dst + (size_t)(dst_row0 + n) * K + k0 + 8 * c)); }
    LDS_WAIT(); asm volatile("" ::: "memory");
}
__device__ __forceinline__ void conv_item_fp8(const float* W, int ldw, int src_col0, int k0, const float* gain, float mul, unsigned char* dst8, int K, int dst_row0, LAS float* scr, int lane) {
    const int kq = lane >> 3, n4 = (lane & 7) * 4;
    f32x4 v[8];
#pragma unroll
    for (int i = 0; i < 8; ++i) v[i] = __builtin_nontemporal_load((const GAS f32x4*)(W + (size_t)(k0 + kq + 8 * i) * ldw + src_col0 + n4));
#pragma unroll
    for (int i = 0; i < 8; ++i) v[i] = v[i] * (gain ? gain[k0 + kq + 8 * i] * mul : mul);
#pragma unroll
    for (int i = 0; i < 8; ++i) { LAS float* s = scr + (kq + 8 * i) * 33 + n4; s[0] = v[i][0]; s[1] = v[i][1]; s[2] = v[i][2]; s[3] = v[i][3]; }
    LDS_WAIT(); asm volatile("" ::: "memory");
    const int c = lane & 7;
#pragma unroll
    for (int j = 0; j < 4; ++j) { const int n = (lane >> 3) + 8 * j; const LAS float* s = scr + (8 * c) * 33 + n;
        typedef unsigned u32x2 __attribute__((ext_vector_type(2))); u32x2 o; o.x = pg8::pk4_fp8(s[0 * 33], s[1 * 33], s[2 * 33], s[3 * 33]); o.y = pg8::pk4_fp8(s[4 * 33], s[5 * 33], s[6 * 33], s[7 * 33]);
        __builtin_nontemporal_store(o, (GAS u32x2*)(dst8 + (size_t)(dst_row0 + n) * K + k0 + 8 * c)); }
    LDS_WAIT(); asm volatile("" ::: "memory");
}
__device__ __forceinline__ int qkv_src_col(int n) {
    if (n < 2560) { const int base = n < 2048 ? 0 : 2048, nn = n - base, t = nn >> 8, r = nn & 255, hf = r >> 7, j = r & 127; return base + (2 * t + (j >> 6)) * 128 + hf * 64 + (j & 63); }
    if (n >= 6144 && n < 8192) { const int base = n < 7168 ? 6144 : 7168, nn = n - base, t = nn >> 8, r = nn & 255, hf = r >> 7, j = r & 127; return base + (4 * t + (j >> 5)) * 64 + hf * 32 + (j & 31); }
    return n;
}
__device__ __forceinline__ int ffn_src_col(int n) { const int t = n >> 8, r = n & 255; return (r < 128) ? (128 * t + r) : (4096 + 128 * t + (r - 128)); }

constexpr int I_W1 = (DM / 64) * (2 * DFF / 32), I_W2 = (DFF / 64) * (DM / 32), I_QKV = (DM / 64) * (NQKV / 32), I_G = (DM / 64) * (NGATE / 32), I_A = (2048 / 64) * (DM / 32), I_B = (1024 / 64) * (DM / 32), I_O = (DM / 64) * (DM / 32);
constexpr int J_W1 = 0, J_W2 = J_W1 + I_W1, J_QKV = J_W2 + I_W2, J_G = J_QKV + I_QKV, J_A = J_G + I_G, J_B = J_A + I_A, J_C = J_B + I_B, J_O = J_C + I_B, J_W3 = J_O + I_O, J_W4 = J_W3 + I_W1, I_LAYER = J_W4 + I_W2;
__device__ __forceinline__ void convert_jobs(Frame& F, int l, int r0, int r1) {
    unsigned char* const ws = launder_p(F.ws);
    const int lane = pg8::lane_id();
    LAS float* scr = (LAS float*)(F.lds + RING_OFF + F.wave * 16384);
    const int gw = F.cid * NWAVES + F.wave, NGW = F.G * NWAVES;
    for (int rr = r0 + gw; rr < r1; rr += NGW) {
        int r = rr;
        const float* W; int ldw, K, N, kind; const float* gain = nullptr; bf16* dst; int drow = 0;
        if (r < I_W1) { W = inp(2) + (size_t)l * DM * 2 * DFF; ldw = 2 * DFF; K = DM; N = 2 * DFF; kind = 1; gain = inp(1) + l * DM; dst = wgt(ws, l, WO_W1); }
        else if ((r -= I_W1) < I_W2) { W = inp(3) + (size_t)l * DFF * DM; ldw = DM; K = DFF; N = DM; kind = 0; dst = wgt(ws, l, WO_W2); }
        else if ((r -= I_W2) < I_QKV) { W = inp(5) + (size_t)l * DM * NQKV; ldw = NQKV; K = DM; N = NQKV; kind = 2; gain = inp(4) + l * DM; dst = wgt(ws, l, WO_QG); }
        else if ((r -= I_QKV) < I_G) { W = inp(6) + (size_t)l * DM * NGATE; ldw = NGATE; K = DM; N = NGATE; kind = 3; gain = inp(4) + l * DM; dst = nullptr; }
        else if ((r -= I_G) < I_A) { W = inp(13) + (size_t)l * 2048 * DM; ldw = DM; K = 2048; N = DM; kind = 0; dst = wgt(ws, l, WO_A); }
        else if ((r -= I_A) < I_B) { W = inp(14) + (size_t)l * 1024 * DM; ldw = DM; K = 2048; N = DM; kind = 0; dst = wgt(ws, l, WO_B); }
        else if ((r -= I_B) < I_B) { W = inp(15) + (size_t)l * 1024 * DM; ldw = DM; K = 2048; N = DM; kind = 0; dst = wgt(ws, l, WO_B) + 1024; }
        else if ((r -= I_B) < I_O) { W = inp(16) + (size_t)l * DM * DM; ldw = DM; K = DM; N = DM; kind = 0; dst = wgt(ws, l, WO_O); }
        else if ((r -= I_O) < I_W1) { W = inp(18) + (size_t)l * DM * 2 * DFF; ldw = 2 * DFF; K = DM; N = 2 * DFF; kind = FFN2_FP8(l) ? 4 : 1; gain = inp(17) + l * DM; dst = wgt(ws, l, WO_W3); }
        else { r -= I_W1; W = inp(19) + (size_t)l * DFF * DM; ldw = DM; K = DFF; N = DM; kind = FFN2_FP8(l) ? 5 : 0; dst = wgt(ws, l, WO_W4); }
        const int nblk = N / 32, kb = r / nblk, nb = r - kb * nblk, n0 = 32 * nb;
        const int sc = kind == 1 ? ffn_src_col(n0) : (kind == 2 ? qkv_src_col(n0) : n0);
        if (kind == 3) conv_item_fp8(W, ldw, n0, 64 * kb, gain, 64.0f, ws + WS_WG8 + (size_t)l * WG8_LAYER, K, n0, scr, lane);
        else if (kind == 4) conv_item_fp8(W, ldw, ffn_src_col(n0), 64 * kb, gain, 64.0f, ws + WS_W3F8, K, n0, scr, lane);
        else if (kind == 5) conv_item_fp8(W, ldw, n0, 64 * kb, nullptr, 64.0f, ws + WS_W4F8, K, n0, scr, lane);
        else conv_item(W, ldw, sc, 64 * kb, gain, dst, K, drow + n0, scr, lane);
    }
}
__device__ __forceinline__ void p0_prologue(Frame& F) {
    unsigned char* const ws = launder_p(F.ws);
    const int lane = pg8::lane_id();
    const int gw = F.vcu * NWAVES + F.wave, NGW = F.G * NWAVES;
    {
        float* cosA = (float*)(ws + WS_ROPE); float* sinA = cosA + 4096 * 64; float* cosC = sinA + 4096 * 64; float* sinC = cosC + 4096 * 32;
        const int gt = gw * 64 + lane, NGT = NGW * 64;
        for (int i = gt; i < 4096 * 96; i += NGT) {
            const bool isA = i < 4096 * 64; const int j = isA ? i : i - 4096 * 64; const int pos = isA ? (j >> 6) : (j >> 5), k = isA ? (j & 63) : (j & 31);
            const float inv = kInvFreq[isA ? k : 2 * k]; const float ang = (float)pos * inv;
            const double rev = (double)ang * 0.15915494309189535; const float fr = (float)(rev - floor(rev));
            const float c = __builtin_amdgcn_cosf(fr), s = __builtin_amdgcn_sinf(fr);
            if (isA) { cosA[j] = c; sinA[j] = s; } else { cosC[j] = c; sinC[j] = s; }
        }
    }
    {
        bf16* XB = (bf16*)(ws + WS_XB); unsigned long long* ss0 = ssbuf(ws, 0);
        for (int m = gw; m < M; m += NGW) {
            const GAS f32x4* xr = (const GAS f32x4*)(inp(0) + (size_t)m * DM) + lane; GAS unsigned long long* o8 = (GAS unsigned long long*)(XB + (size_t)m * DM) + lane; float s = 0.f;
#pragma unroll 4
            for (int j = 0; j < 16; ++j) { const f32x4 v = xr[64 * j]; s += (v.x * v.x + v.y * v.y) + (v.z * v.z + v.w * v.w);
                o8[64 * j] = (unsigned long long)pk2(v.x, v.y) | ((unsigned long long)pk2(v.z, v.w) << 32); }
            s = wave_sum(s);
            if (lane == 0) ss0[m] = (unsigned long long)(s * pg8::SS_SCALE + 0.5f);
        }
    }
}

namespace att {
typedef float f32x16 __attribute__((ext_vector_type(16)));
typedef short bf16x8 __attribute__((ext_vector_type(8)));
typedef short v4i16_t __attribute__((ext_vector_type(4)));
constexpr int RS = 272  , RSV = 320  , TILE = 64 * RS, BUF = TILE + 64 * RSV  , OFF_X = 0  , OFF_FLAG = 2 * BUF;
static_assert(2 * BUF >= 65536 && OFF_FLAG + 64 <= RING_BYTES, "attention LDS map");
constexpr float NEG_DONE = -160.0f;
struct TileRegs { v4u k[2], v[2]; };
__device__ __forceinline__ void tile_load(TileRegs& r, const bf16* Kg, int ldk, const bf16* Vg, int ldv, int tid_) {
    const int tid = pg8::launder_v(tid_);
#pragma unroll
    for (int i = 0; i < 2; ++i) { const int c = tid + 512 * i, row = c >> 4, ch = c & 15;
        r.k[i] = *(const GAS v4u*)(Kg + (unsigned)(row * ldk + ch * 8)); r.v[i] = *(const GAS v4u*)(Vg + (unsigned)(row * ldv + ch * 8)); }
}
__device__ __forceinline__ void tile_store(LAS unsigned char* buf, const TileRegs& r, int tid) {
#pragma unroll
    for (int i = 0; i < 2; ++i) { const int c = tid + 512 * i, row = c >> 4, ch = c & 15;
        *(LAS v4u*)(buf + row * RS + ch * 16) = r.k[i]; *(LAS v4u*)(buf + TILE + row * RSV + ch * 16) = r.v[i]; }
}
template <int NK> __device__ __forceinline__ void qk(f32x16 (&s)[2], const LAS unsigned char* kt, const bf16x8 (&qf)[NK], int lane) {
    const int r = lane & 31, h = lane >> 5;
#pragma unroll
    for (int kvt = 0; kvt < 2; ++kvt) {
        f32x16 a = {0.f, 0.f, 0.f, 0.f, 0.f, 0.f, 0.f, 0.f, 0.f, 0.f, 0.f, 0.f, 0.f, 0.f, 0.f, 0.f};
#pragma unroll
        for (int ks = 0; ks < NK; ++ks) { const bf16x8 kf = *(const LAS bf16x8*)(kt + (32 * kvt + r) * RS + (16 * ks + 8 * h) * 2); a = __builtin_amdgcn_mfma_f32_32x32x16_bf16(kf, qf[ks], a, 0, 0, 0); }
        s[kvt] = a; }
}
__device__ __forceinline__ void pv(f32x16 (&o)[4], const f32x16 (&p)[2], const LAS unsigned char* vt, int lane) {
    const int h = lane >> 5, g = (lane >> 4) & 1, i = lane & 15;
    const LAS unsigned char* vb = vt + (4 * h + (i >> 2)) * RSV + (16 * g + 4 * (i & 3)) * 2;
#pragma unroll
    for (int kvt = 0; kvt < 2; ++kvt)
#pragma unroll
        for (int s = 0; s < 2; ++s) {
            pg8::u32x4 pw; pw.x = pg8::cvt_pk_bf16(p[kvt][8 * s + 0], p[kvt][8 * s + 1]); pw.y = pg8::cvt_pk_bf16(p[kvt][8 * s + 2], p[kvt][8 * s + 3]);
            pw.z = pg8::cvt_pk_bf16(p[kvt][8 * s + 4], p[kvt][8 * s + 5]); pw.w = pg8::cvt_pk_bf16(p[kvt][8 * s + 6], p[kvt][8 * s + 7]);
            const bf16x8 pb = __builtin_bit_cast(bf16x8, pw);
#pragma unroll
            for (int dt = 0; dt < 4; ++dt) { const LAS unsigned char* a = vb + (32 * kvt + 16 * s) * RSV + 64 * dt;
                const v4i16_t lo = __builtin_amdgcn_ds_read_tr16_b64_v4i16((LAS v4i16_t*)a), hi = __builtin_amdgcn_ds_read_tr16_b64_v4i16((LAS v4i16_t*)(a + 8 * RSV));
                const bf16x8 va = {lo.x, lo.y, lo.z, lo.w, hi.x, hi.y, hi.z, hi.w};
                o[dt] = __builtin_amdgcn_mfma_f32_32x32x16_bf16(va, pb, o[dt], 0, 0, 0); } }
}
__device__ __forceinline__ void store_ot(bf16* dst, const f32x16 (&o)[4], float scale, int hi) {
#pragma unroll
    for (int dt = 0; dt < 4; ++dt)
#pragma unroll
        for (int p = 0; p < 2; ++p) { const int r0 = 8 * p, r1 = 8 * p + 4;
            unsigned ax = pg8::cvt_pk_bf16(o[dt][r0] * scale, o[dt][r0 + 1] * scale), ay = pg8::cvt_pk_bf16(o[dt][r0 + 2] * scale, o[dt][r0 + 3] * scale);
            unsigned bx = pg8::cvt_pk_bf16(o[dt][r1] * scale, o[dt][r1 + 1] * scale), by = pg8::cvt_pk_bf16(o[dt][r1 + 2] * scale, o[dt][r1 + 3] * scale);
            { const auto r = __builtin_amdgcn_permlane32_swap(ax, bx, false, false); ax = r[0]; bx = r[1]; }
            { const auto r = __builtin_amdgcn_permlane32_swap(ay, by, false, false); ay = r[0]; by = r[1]; }
            v4u w; w.x = ax; w.y = ay; w.z = bx; w.w = by;
            *(GAS v4u*)(dst + 32 * dt + 16 * p + 8 * hi) = w; }
}
template <int NK> __device__ __forceinline__ void load_q(bf16x8 (&qf)[NK], const bf16* qrow_ptr, int hi) {
#pragma unroll
    for (int ks = 0; ks < NK; ++ks) qf[ks] = *(const GAS bf16x8*)(qrow_ptr + 16 * ks + 8 * hi);
}
#define ATT_BAR() do { asm volatile("s_waitcnt lgkmcnt(0)" ::: "memory"); __builtin_amdgcn_s_barrier(); asm volatile("" ::: "memory"); } while (0)
__device__ __forceinline__ void softmax_tile(f32x16 (&s)[2], float& m, float& lsum, f32x16 (&o)[4]) {
    float mx = -INFINITY;
#pragma unroll
    for (int kvt = 0; kvt < 2; ++kvt)
#pragma unroll
        for (int r = 0; r < 16; ++r) mx = fmaxf(mx, s[kvt][r]);
    mx = pg8::max32(mx);
    const float mn = fmaxf(m, mx);
    if (__any(mn > m)) { const float alpha = __builtin_amdgcn_exp2f(m - mn); m = mn; lsum *= alpha;
#pragma unroll
        for (int dt = 0; dt < 4; ++dt) o[dt] = o[dt] * alpha; }
    float ps = 0.f;
#pragma unroll
    for (int kvt = 0; kvt < 2; ++kvt)
#pragma unroll
        for (int r = 0; r < 16; ++r) { const float e = __builtin_amdgcn_exp2f(s[kvt][r] - m); s[kvt][r] = e; ps += e; }
    lsum += ps;
}
__device__ __forceinline__ void pv_pk(f32x16 (&o)[4], const unsigned (&pw)[16], const LAS unsigned char* vt, int lane) {
    const int h = lane >> 5, g = (lane >> 4) & 1, i = lane & 15;
    const LAS unsigned char* vb = vt + (4 * h + (i >> 2)) * RSV + (16 * g + 4 * (i & 3)) * 2;
#pragma unroll
    for (int ks = 0; ks < 4; ++ks) {
        pg8::u32x4 w; w.x = pw[4 * ks]; w.y = pw[4 * ks + 1]; w.z = pw[4 * ks + 2]; w.w = pw[4 * ks + 3];
        const bf16x8 pb = __builtin_bit_cast(bf16x8, w);
#pragma unroll
        for (int dt = 0; dt < 4; ++dt) { const LAS unsigned char* a = vb + (16 * ks) * RSV + 64 * dt;
            const v4i16_t lo = __builtin_amdgcn_ds_read_tr16_b64_v4i16((LAS v4i16_t*)a), hi = __builtin_amdgcn_ds_read_tr16_b64_v4i16((LAS v4i16_t*)(a + 8 * RSV));
            const bf16x8 va = {lo.x, lo.y, lo.z, lo.w, hi.x, hi.y, hi.z, hi.w};
            o[dt] = __builtin_amdgcn_mfma_f32_32x32x16_bf16(va, pb, o[dt], 0, 0, 0); } }
}
template <bool MASK> __device__ __forceinline__ void softmax_pk(const f32x16 (&s_)[2], unsigned (&pw)[16], float& m, float& lsum, float& alpha, int kv0, int q, int hi) {
    f32x16 s[2] = {s_[0], s_[1]};
    if (MASK) {
#pragma unroll
        for (int kvt = 0; kvt < 2; ++kvt)
#pragma unroll
            for (int r = 0; r < 16; ++r) { const int kv = kv0 + 32 * kvt + (r & 3) + 8 * (r >> 2) + 4 * hi; if (kv > q) s[kvt][r] = -INFINITY; }
    }
    float mx0 = fmaxf(fmaxf(s[0][0], s[0][1]), s[0][2]), mx1 = fmaxf(fmaxf(s[1][0], s[1][1]), s[1][2]);
#pragma unroll
    for (int r = 3; r < 15; r += 2) { mx0 = fmaxf(fmaxf(mx0, s[0][r]), s[0][r + 1]); mx1 = fmaxf(fmaxf(mx1, s[1][r]), s[1][r + 1]); }
    float mx = fmaxf(fmaxf(mx0, mx1), fmaxf(s[0][15], s[1][15]));
    mx = pg8::max32(mx);
    const float mn = mx > m + 8.0f ? mx : m;
    alpha = __builtin_amdgcn_exp2f(m - mn); m = mn;
    float ps0 = 0.f, ps1 = 0.f;
#pragma unroll
    for (int kvt = 0; kvt < 2; ++kvt)
#pragma unroll
        for (int r2 = 0; r2 < 8; ++r2) { const float e0 = __builtin_amdgcn_exp2f(s[kvt][2 * r2] - mn), e1 = __builtin_amdgcn_exp2f(s[kvt][2 * r2 + 1] - mn); ps0 += e0; ps1 += e1;
            pw[8 * kvt + r2] = pg8::cvt_pk_bf16(e0, e1); }
    lsum = lsum * alpha + (ps0 + ps1);
    asm volatile("" : "+v"(pw[0]), "+v"(pw[1]), "+v"(pw[2]), "+v"(pw[3]), "+v"(pw[4]), "+v"(pw[5]), "+v"(pw[6]), "+v"(pw[7]));
    asm volatile("" : "+v"(pw[8]), "+v"(pw[9]), "+v"(pw[10]), "+v"(pw[11]), "+v"(pw[12]), "+v"(pw[13]), "+v"(pw[14]), "+v"(pw[15]));
    asm volatile("" : "+v"(lsum), "+v"(m), "+v"(alpha));
}
#define SGB(mask, n) __builtin_amdgcn_sched_group_barrier(mask, n, 0)
__device__ __forceinline__ void c_step_pipeline() {
    SGB(0x100, 8);
#pragma unroll
    for (int i = 0; i < 24; ++i) { SGB(0x008, 1); if (i < 12) SGB(0x100, 2); else if (i < 20) SGB(0x100, 1); SGB(0x402, 6); }
}
}

__device__ __forceinline__ void attn_a(Frame& F, int l) {
    using namespace att;
    unsigned char* const ws = launder_p(F.ws);
    const bf16* QA = (const bf16*)(ws + WS_QKV); const bf16* KA = QA + (size_t)M * 2048; const bf16* VA = KA + (size_t)M * 512; bf16* OA = (bf16*)(ws + WS_OA);
    LAS unsigned char* lds = F.lds + RING_OFF;
    const int lane = pg8::lane_id(), wave = F.wave, tid = wave * 64 + lane, r32 = lane & 31, hi = lane >> 5;
    for (int u = F.vcu; u < 1024; u += F.G) {
        const int qb = u & 63, kvh = (u >> 6) & 3, b = u >> 8, hq = 4 * kvh + (wave >> 1), qw = qb * 64 + 32 * (wave & 1), q = qw + r32; const size_t qrow = (size_t)b * SEQ + q;
        bf16x8 qf[8]; load_q<8>(qf, QA + qrow * 2048 + hq * 128, hi);
        float m = inp(7)[l * 16 + hq] * 1.44269504089f, lsum = hi ? 0.f : 1.f;
        f32x16 o[4];
#pragma unroll
        for (int dt = 0; dt < 4; ++dt)
#pragma unroll
            for (int r = 0; r < 16; ++r) o[dt][r] = 0.f;
        const int t_lo = qb - 2 < 0 ? 0 : qb - 2, t_hi = qb;
        const bf16* Kb = KA + (size_t)b * SEQ * 512 + kvh * 128; const bf16* Vb = VA + (size_t)b * SEQ * 512 + kvh * 128;
        TileRegs tr; tile_load(tr, Kb + (size_t)t_lo * 64 * 512, 512, Vb + (size_t)t_lo * 64 * 512, 512, tid);
        tile_store(lds, tr, tid); ATT_BAR();
        if (t_lo < t_hi) tile_load(tr, Kb + (size_t)(t_lo + 1) * 64 * 512, 512, Vb + (size_t)(t_lo + 1) * 64 * 512, 512, tid);
        for (int t = t_lo; t <= t_hi; ++t) {
            LAS unsigned char* cur = lds + ((t - t_lo) & 1) * BUF; LAS unsigned char* nxt = lds + ((t - t_lo + 1) & 1) * BUF;
            if (t < t_hi) tile_store(nxt, tr, tid);
            if (t + 1 < t_hi) tile_load(tr, Kb + (size_t)(t + 2) * 64 * 512, 512, Vb + (size_t)(t + 2) * 64 * 512, 512, tid);
            const int kv0 = 64 * t;
            if (kv0 <= qw + 31 && kv0 + 63 > qw - 128) {
                f32x16 s[2]; qk<8>(s, cur, qf, lane);
                if (t == t_hi) {
#pragma unroll
                    for (int kvt = 0; kvt < 2; ++kvt)
#pragma unroll
                        for (int r = 0; r < 16; ++r) { const int kv = kv0 + 32 * kvt + (r & 3) + 8 * (r >> 2) + 4 * hi; if (kv > q) s[kvt][r] = -INFINITY; }
                } else if (t + 2 == t_hi) {
#pragma unroll
                    for (int kvt = 0; kvt < 2; ++kvt)
#pragma unroll
                        for (int r = 0; r < 16; ++r) { const int kv = kv0 + 32 * kvt + (r & 3) + 8 * (r >> 2) + 4 * hi; if (q - kv >= 128) s[kvt][r] = -INFINITY; }
                }
                softmax_tile(s, m, lsum, o);
                pv(o, s, cur + TILE, lane);
            }
            ATT_BAR();
        }
        const float lt = pg8::sum32(lsum);
        store_ot(OA + qrow * 2048 + hq * 128, o, 1.0f / lt, hi);
    }
}
__device__ __forceinline__ void attn_b(Frame& F, int l) {
    using namespace att;
    unsigned char* const ws = launder_p(F.ws);
    const bf16* QB = (const bf16*)(ws + WS_QKV) + (size_t)M * 3072; const bf16* KB = QB + (size_t)M * 1024; const bf16* VB = KB + (size_t)M * 1024; bf16* OB = (bf16*)(ws + WS_OA) + (size_t)M * 2048;
    LAS unsigned char* lds = F.lds + RING_OFF; volatile LAS float* flags = (volatile LAS float*)(lds + OFF_FLAG);
    const int lane = pg8::lane_id(), wave = F.wave, tid = wave * 64 + lane, r32 = lane & 31, hi = lane >> 5;
    for (int u = F.vcu; u < 512; u += F.G) {
        const int qb = u & 15, h = (u >> 4) & 7, b = u >> 7, q0 = qb * 256, qw = q0 + 32 * wave, q = qw + r32; const size_t qrow = (size_t)b * SEQ + q;
        bf16x8 qf[8]; load_q<8>(qf, QB + qrow * 1024 + h * 128, hi);
        float run = 0.f;
        f32x16 o[4];
#pragma unroll
        for (int dt = 0; dt < 4; ++dt)
#pragma unroll
            for (int r = 0; r < 16; ++r) o[dt][r] = 0.f;
        const int t_hi = qb * 4 + 3;
        const bf16* Kb = KB + (size_t)b * SEQ * 1024 + h * 128; const bf16* Vb = VB + (size_t)b * SEQ * 1024 + h * 128;
        TileRegs tr; tile_load(tr, Kb + (size_t)t_hi * 64 * 1024, 1024, Vb + (size_t)t_hi * 64 * 1024, 1024, tid);
        tile_store(lds, tr, tid); ATT_BAR();
        tile_load(tr, Kb + (size_t)(t_hi - 1) * 64 * 1024, 1024, Vb + (size_t)(t_hi - 1) * 64 * 1024, 1024, tid);
        for (int t = t_hi; t >= 0; --t) {
            const int par = (t_hi - t) & 1;
            LAS unsigned char* cur = lds + par * BUF; LAS unsigned char* nxt = lds + (par ^ 1) * BUF;
            if (t > 0) tile_store(nxt, tr, tid);
            if (t > 1) tile_load(tr, Kb + (size_t)(t - 2) * 64 * 1024, 1024, Vb + (size_t)(t - 2) * 64 * 1024, 1024, tid);
            const int kv0 = 64 * t;
            float wmax = wave_max(run);
            if (kv0 < qw + 31 && wmax >= NEG_DONE) {
                f32x16 s[2]; qk<8>(s, cur, qf, lane);
                f32x16 l1[2];
#pragma unroll
                for (int kvt = 0; kvt < 2; ++kvt)
#pragma unroll
                    for (int r = 0; r < 16; ++r) { const int kv = kv0 + 32 * kvt + (r & 3) + 8 * (r >> 2) + 4 * hi; const float z = s[kvt][r];
                        const float lb = fminf(z, 0.f) - __builtin_amdgcn_logf(1.0f + __builtin_amdgcn_exp2f(-fabsf(z))); const bool valid = kv < q;
                        s[kvt][r] = valid ? lb : -INFINITY; l1[kvt][r] = valid ? (lb - z) : 0.f; }
                float gs[8], og[8];
#pragma unroll
                for (int gi = 0; gi < 8; ++gi) { const int kvt = gi >> 2, rq = gi & 3; gs[gi] = (l1[kvt][4 * rq] + l1[kvt][4 * rq + 1]) + (l1[kvt][4 * rq + 2] + l1[kvt][4 * rq + 3]); og[gi] = pg8::xor32(gs[gi], hi); }
                float above = run;
#pragma unroll
                for (int gi = 7; gi >= 0; --gi) { const int kvt = gi >> 2, rq = gi & 3;
                    const float sg = above + (hi ? 0.f : og[gi]);
                    const float a3 = sg, a2 = a3 + l1[kvt][4 * rq + 3], a1 = a2 + l1[kvt][4 * rq + 2], a0 = a1 + l1[kvt][4 * rq + 1];
                    s[kvt][4 * rq + 3] = __builtin_amdgcn_exp2f(s[kvt][4 * rq + 3] + a3); s[kvt][4 * rq + 2] = __builtin_amdgcn_exp2f(s[kvt][4 * rq + 2] + a2);
                    s[kvt][4 * rq + 1] = __builtin_amdgcn_exp2f(s[kvt][4 * rq + 1] + a1); s[kvt][4 * rq + 0] = __builtin_amdgcn_exp2f(s[kvt][4 * rq + 0] + a0);
                    above += gs[gi] + og[gi]; }
                run = above;
                pv(o, s, cur + TILE, lane);
                wmax = wave_max(run);
            }
            if (lane == 0) flags[par * 8 + wave] = wmax;
            ATT_BAR();
            float gmax = flags[par * 8];
#pragma unroll
            for (int w = 1; w < 8; ++w) gmax = fmaxf(gmax, flags[par * 8 + w]);
            if (gmax < NEG_DONE) break;
        }
        store_ot(OB + qrow * 2048 + h * 128, o, 1.0f, hi);
        ATT_BAR();
    }
}
#define C_SLOT(j) do { const int kj_ = (j) < nt ? (j) : nt - 1, vj_ = (j) < 2 ? 0 : ((j) - 2 < nt ? (j) - 2 : nt - 1); tile_load(tr, Kb + (size_t)kj_ * 64 * 1024, 1024, Vb + (size_t)vj_ * 64 * 1024, 1024, tid); } while (0)
#define C_RESCALE() do { if (__any(alpha != 1.0f)) { _Pragma("unroll") for (int dt = 0; dt < 4; ++dt) o[dt] = o[dt] * alpha; } } while (0)
#define C_STEP(SC, SN, MASK, T) do { const int t_ = (T); LAS unsigned char* cur = lds + ((t_ + 1) & 1) * BUF; LAS unsigned char* nxt = lds + (t_ & 1) * BUF; \
        tile_store(nxt, tr, tid); C_SLOT(t_ + 3); C_RESCALE(); \
        pv_pk(o, pw, cur + TILE, lane); qk<4>(SN, cur + 128 * c, qf, lane); softmax_pk<MASK>(SC, pw, m, lsum, alpha, 64 * t_, q, hi); c_step_pipeline(); \
        ATT_BAR(); } while (0)
__device__ __forceinline__ void attn_c(Frame& F, int l) {
    using namespace att;
    unsigned char* const ws = launder_p(F.ws);
    const bf16* QC = (const bf16*)(ws + WS_QKV) + (size_t)M * 6144; const bf16* KC = QC + (size_t)M * 1024; const bf16* VC = KC + (size_t)M * 1024; bf16* OC = (bf16*)(ws + WS_OA) + (size_t)M * 2048 + 1024;
    LAS unsigned char* lds = F.lds + RING_OFF; LAS float* xch = (LAS float*)(lds + OFF_X);
    const int lane = pg8::lane_id(), wave = F.wave, tid = wave * 64 + lane, r32 = lane & 31, hi = lane >> 5, wq = wave & 3, c = wave >> 2;
    const float lam_init = 0.8f - 0.6f * expf(-0.3f * (float)l);
    const float lam = expf(wave_sum(inp(8)[l * 64 + lane] * inp(9)[l * 64 + lane])) - expf(wave_sum(inp(10)[l * 64 + lane] * inp(11)[l * 64 + lane])) + lam_init;
    const float* gptr = inp(12) + l * 128;
#define C_FETCH(p_, half_) do { const int b_ = (p_) >> 7, h_ = ((p_) >> 4) & 7, qb_ = (half_) ? 31 - ((p_) & 15) : ((p_) & 15); \
        const bf16* Kn_ = KC + (size_t)b_ * SEQ * 1024 + h_ * 128; const bf16* Vn_ = VC + (size_t)b_ * SEQ * 1024 + h_ * 128; \
        tile_load(tr, Kn_, 1024, Vn_, 1024, tid); tile_load(tr1, Kn_ + (size_t)64 * 1024, 1024, Vn_, 1024, tid); \
        load_q<4>(qf, QC + ((size_t)b_ * SEQ + qb_ * 128 + 32 * wq + r32) * 1024 + h_ * 128 + 64 * c, hi); } while (0)
    TileRegs tr, tr1; bf16x8 qf[4];
    if (F.vcu < 512) C_FETCH(F.vcu, 0);
    for (int p = F.vcu; p < 512; p += F.G) {
        const int bh = p >> 4, x = p & 15, b = bh >> 3, h = bh & 7;
        const bf16* Kb = KC + (size_t)b * SEQ * 1024 + h * 128; const bf16* Vb = VC + (size_t)b * SEQ * 1024 + h * 128;
        for (int half = 0; half < 2; ++half) {
            const int qblk = half ? 31 - x : x, q0 = qblk * 128, qw = q0 + 32 * wq, q = qw + r32; const size_t qrow = (size_t)b * SEQ + q;
            float m = -INFINITY, lsum = 0.f, alpha = 1.0f;
            f32x16 o[4];
#pragma unroll
            for (int dt = 0; dt < 4; ++dt)
#pragma unroll
                for (int r = 0; r < 16; ++r) o[dt][r] = 0.f;
            unsigned pw[16];
#pragma unroll
            for (int i = 0; i < 16; ++i) pw[i] = 0u;
            const int nt = 2 * qblk + 2;
            f32x16 sA[2], sB[2];
            tile_store(lds, tr, tid); tile_store(lds + BUF, tr1, tid); C_SLOT(2); ATT_BAR();
            qk<4>(sA, lds + 128 * c, qf, lane); ATT_BAR();
            for (int t = 0; t + 2 < nt; t += 2) { C_STEP(sA, sB, false, t); C_STEP(sB, sA, false, t + 1); }
            C_STEP(sA, sB, true, nt - 2); C_STEP(sB, sA, true, nt - 1);
            C_RESCALE(); pv_pk(o, pw, lds + ((nt + 1) & 1) * BUF + TILE, lane);
            ATT_BAR();
            const float lt = pg8::sum32(lsum);
            if (c == 1) { const float sc = lam / lt;
#pragma unroll
                for (int dt = 0; dt < 4; ++dt)
#pragma unroll
                    for (int r = 0; r < 16; ++r) xch[(wq * 64 + dt * 16 + r) * 64 + lane] = o[dt][r] * sc; }
            ATT_BAR();
            float ss = 0.f;
            if (c == 0) { const float sc = 1.0f / lt;
#pragma unroll
                for (int dt = 0; dt < 4; ++dt)
#pragma unroll
                    for (int r = 0; r < 16; ++r) { const float y = o[dt][r] * sc - xch[(wq * 64 + dt * 16 + r) * 64 + lane]; o[dt][r] = y; ss += y * y; } }
            asm volatile("" ::: "memory");
            { const int pn = half ? p + F.G : p, hn = half ^ 1; if (pn < 512) C_FETCH(pn, hn); }
            if (c == 0) {
                ss = pg8::sum32(ss);
                const float rn = rsqrtf(ss * (1.0f / 128.0f) + 1e-5f) * (1.0f - lam_init);
#pragma unroll
                for (int dt = 0; dt < 4; ++dt)
#pragma unroll
                    for (int rq = 0; rq < 4; ++rq) { const f32x4 g = *(const GAS f32x4*)(gptr + 32 * dt + 8 * rq + 4 * hi);
                        o[dt][4 * rq] *= g.x * rn; o[dt][4 * rq + 1] *= g.y * rn; o[dt][4 * rq + 2] *= g.z * rn; o[dt][4 * rq + 3] *= g.w * rn; }
                store_ot(OC + qrow * 2048 + h * 128, o, 1.0f, hi); }
            ATT_BAR();
        }
    }
}

__device__ __forceinline__ void final_norm(Frame& F) {
    unsigned char* const ws = launder_p(F.ws);
    const bf16* XB = (const bf16*)(ws + WS_XB); const float* g = inp(20); const int lane = pg8::lane_id();
    const int gw = F.vcu * NWAVES + F.wave, NGW = F.G * NWAVES;
    for (int m = gw; m < M; m += NGW) {
        const GAS v4u* xr = (const GAS v4u*)(XB + (size_t)m * DM) + lane; GAS f32x4* orow = (GAS f32x4*)(F.out + (size_t)m * DM) + 2 * lane; const GAS f32x4* gr = (const GAS f32x4*)g + 2 * lane;
        f32x4 v[16]; float s = 0.f;
#pragma unroll
        for (int j = 0; j < 8; ++j) { pg8::unpack8(xr[64 * j], v[2 * j], v[2 * j + 1]);
            s += (v[2 * j].x * v[2 * j].x + v[2 * j].y * v[2 * j].y) + (v[2 * j].z * v[2 * j].z + v[2 * j].w * v[2 * j].w) + (v[2 * j + 1].x * v[2 * j + 1].x + v[2 * j + 1].y * v[2 * j + 1].y) + (v[2 * j + 1].z * v[2 * j + 1].z + v[2 * j + 1].w * v[2 * j + 1].w); }
        const float rs = rsqrtf(wave_sum(s) * (1.0f / DM) + 1e-6f);
#pragma unroll
        for (int j = 0; j < 8; ++j) { orow[128 * j] = v[2 * j] * rs * gr[128 * j]; orow[128 * j + 1] = v[2 * j + 1] * rs * gr[128 * j + 1]; }
    }
}

#define GP(Epi) pg8::gemm_phase<Epi, pg8::StaticOrder, true, true>
__device__ __forceinline__ void ph_ffn_in(Frame& F, int l, int which) {
    unsigned char* const ws = launder_p(F.ws);
    pg8::StaticOrder S; S.init(M, 2 * DFF, launder_i(F.G), launder_i(F.cid));
    if (which && FFN2_FP8(l)) {
        pg8::Gemm g{(const bf16*)(ws + WS_XB8), (const bf16*)(ws + WS_W3F8), M, 2 * DFF, DM / 2};
        pg8::EpiSwigluT<true> E{(bf16*)(ws + WS_HID), ssbuf(ws, 3 * l + 2), {}, 1.0f / 64.0f}; { pg8::Unit u0; u0.pm = 0; u0.pn = 0; E.R.pm = -1; if (S.next(0, u0)) E.R.load(E.ss, u0.pm, F.wave, pg8::lane_id(), 1.0f / 64.0f); }
        pg8::gemm_phase<pg8::EpiSwigluT<true>, pg8::StaticOrder, true, true, true>(F.lds + RING_OFF, g, S, E, F.wave);
        return;
    }
    pg8::Gemm g{(const bf16*)(ws + WS_XB), wgt(ws, l, which ? WO_W3 : WO_W1), M, 2 * DFF, DM};
    pg8::EpiSwiglu E{(bf16*)(ws + WS_HID), ssbuf(ws, 3 * l + (which ? 2 : 0)), {}, 1.0f}; { pg8::Unit u0; u0.pm = 0; u0.pn = 0; E.R.pm = -1; if (S.next(0, u0)) E.R.load(E.ss, u0.pm, F.wave, pg8::lane_id(), 1.0f); }
    GP(pg8::EpiSwiglu)(F.lds + RING_OFF, g, S, E, F.wave);
}
__device__ __forceinline__ void ph_ffn_out(Frame& F, int l, int which) {
    unsigned char* const ws = launder_p(F.ws);
    pg8::Gemm g{(const bf16*)(ws + WS_HID), wgt(ws, l, which ? WO_W4 : WO_W2), M, DM, DFF}; pg8::StaticOrder S; S.init(M, DM, launder_i(F.G), launder_i(F.cid));
    if (which == 0) {
        pg8::EpiResid<true> E{l == 0 ? inp(0) : nullptr, (bf16*)(ws + WS_XB), ssbuf(ws, 3 * l + 1), 0.5f, (long)WS_XB8 - (long)WS_XB};
        GP(pg8::EpiResid<true>)(F.lds + RING_OFF, g, S, E, F.wave);
    } else if (FFN2_FP8(l)) {
        pg8::Gemm g8{(const bf16*)(ws + WS_HID), (const bf16*)(ws + WS_W4F8), M, DM, DFF / 2};
        pg8::EpiResid<false> E{nullptr, (bf16*)(ws + WS_XB), ssbuf(ws, 3 * (l + 1)), 0.5f / 64.0f, 0};
        pg8::gemm_phase<pg8::EpiResid<false>, pg8::StaticOrder, true, true, true>(F.lds + RING_OFF, g8, S, E, F.wave);
    } else {
        pg8::EpiResid<false> E{nullptr, (bf16*)(ws + WS_XB), ssbuf(ws, 3 * (l + 1)), 0.5f, 0};
        GP(pg8::EpiResid<false>)(F.lds + RING_OFF, g, S, E, F.wave);
    }
}
__device__ __forceinline__ void ph_qkvg(Frame& F, int l) {
    unsigned char* const ws = launder_p(F.ws);
    pg8::Gemm g{(const bf16*)(ws + WS_XB), wgt(ws, l, WO_QG), M, NQKV, DM}; pg8::StaticOrder S; S.init(M, NQKV, launder_i(F.G), launder_i(F.cid));
    const float* cosA = (const float*)(ws + WS_ROPE);
    pg8::EpiQKVG E{(bf16*)(ws + WS_QKV), (bf16*)(ws + WS_GATES), ssbuf(ws, 3 * l + 1), cosA, cosA + 4096 * 64, cosA + 2 * 4096 * 64, cosA + 2 * 4096 * 64 + 4096 * 32, {}}; { pg8::Unit u0; u0.pm = 0; u0.pn = 0; E.R.pm = -1; if (S.next(0, u0)) E.R.load(E.ss, u0.pm, F.wave, pg8::lane_id(), 1.0f); }
    GP(pg8::EpiQKVG)(F.lds + RING_OFF, g, S, E, F.wave);
}
__device__ __forceinline__ void ph_gates(Frame& F, int l) {
    unsigned char* const ws = launder_p(F.ws);
    pg8::Gemm g{(const bf16*)(ws + WS_XB8), (const bf16*)(ws + WS_WG8 + (size_t)l * WG8_LAYER), M, NGATE, DM / 2}; pg8::StaticOrder S; S.init(M, NGATE, launder_i(F.G), launder_i(F.cid));
    pg8::EpiGates E{ws + WS_GATES, ssbuf(ws, 3 * l + 1), {}}; { pg8::Unit u0; u0.pm = 0; u0.pn = 0; E.R.pm = -1; if (S.next(0, u0)) E.R.load(E.ss, u0.pm, F.wave, pg8::lane_id(), 1.0f / 64.0f); }
    pg8::gemm_phase<pg8::EpiGates, pg8::StaticOrder, true, true, true>(F.lds + RING_OFF, g, S, E, F.wave);
}
__device__ __forceinline__ void ph_branches(Frame& F, int l) {
    unsigned char* const ws = launder_p(F.ws);
    const bf16* OA = (const bf16*)(ws + WS_OA);
    pg8::MergeGemm g{OA, OA + (size_t)M * 2048, wgt(ws, l, WO_A), wgt(ws, l, WO_B), ws + WS_GATES, (bf16*)(ws + WS_MB)};
    pg8::StaticOrder S; S.init(M, DM, launder_i(F.G), launder_i(F.cid));
    pg8::gemm_phase_merge(F.lds + RING_OFF, g, S, F.wave);
}
__device__ __forceinline__ void ph_wout(Frame& F, int l) {
    unsigned char* const ws = launder_p(F.ws);
    pg8::Gemm g{(const bf16*)(ws + WS_MB), wgt(ws, l, WO_O), M, DM, DM}; pg8::StaticOrder S; S.init(M, DM, launder_i(F.G), launder_i(F.cid));
    if (FFN2_FP8(l)) { pg8::EpiResid<true> E{nullptr, (bf16*)(ws + WS_XB), ssbuf(ws, 3 * l + 2), 1.0f / 255.0f, (long)WS_XB8 - (long)WS_XB}; GP(pg8::EpiResid<true>)(F.lds + RING_OFF, g, S, E, F.wave); return; }
    pg8::EpiResid<false> E{nullptr, (bf16*)(ws + WS_XB), ssbuf(ws, 3 * l + 2), 1.0f / 255.0f, 0};
    GP(pg8::EpiResid<false>)(F.lds + RING_OFF, g, S, E, F.wave);
}

__global__ void __launch_bounds__(NWAVES * 64, 2) mk_fwd(Args args) {
    extern __shared__ __attribute__((aligned(16))) unsigned char lds[];
    Frame F;
    F.lds = (LAS unsigned char*)lds;
    F.MISC = (volatile LAS unsigned*)(F.lds + MISC_OFF);
    F.wave = __builtin_amdgcn_readfirstlane((int)threadIdx.x >> 6); asm volatile("" : "+s"(F.wave));
    F.G = gridDim.x; { const int bx = blockIdx.x; F.vcu = (F.G % 8 == 0) ? (bx % 8) * (F.G / 8) + bx / 8 : bx; }
    F.ws = args.ws; F.out = args.out;
    F.ctl = (gu32*)(args.ws + WS_CTL);
    for (int u = threadIdx.x; u < (LDS_BYTES - LDSCTL_OFF) / 4; u += NWAVES * 64) ((LAS unsigned*)(F.lds + LDSCTL_OFF))[u] = 0u;
    __syncthreads();
#if MK_PER_PHASE
    const int lo = args.ph_lo, hi = args.ph_hi;
#else
    constexpr int lo = 0, hi = NPH;
#endif
    XcdBarrier bar; bar.bar = (unsigned*)(F.ctl + CW_BAR) + args.li * XCD_BAR_WORDS; bar.x = 0; bar.st = nullptr;
    if (hi - lo > 1) bar = xcd_barrier_post((unsigned*)(F.ctl + CW_BAR) + args.li * XCD_BAR_WORDS, F.MISC + 8);
    F.cid = blockIdx.x;
    if (hi - lo > 1 && F.wave == 0 && pg8::lane_id() == 0) { const unsigned x = xb_xcc_id(); F.MISC[10] = x; F.MISC[11] = xb_add((unsigned*)(F.ctl + CW_TICKET) + 64 * x, 1u); }
#define IN(k) (lo <= (k) && (k) < hi)
#define SEAM(k) do { if (IN(k) && IN((k) + 1)) xcd_barrier(bar, F.wave); } while (0)

    if (IN(0)) { p0_prologue(F); convert_jobs(F, 0, J_W1, J_W2); SEAM(0); }
    if (hi - lo > 1) {
        if (F.wave == 0 && pg8::lane_id() == 0) { unsigned ok = (F.G % 8 == 0) ? 1u : 0u; unsigned* bw = (unsigned*)(F.ctl + CW_BAR) + args.li * XCD_BAR_WORDS;
            for (unsigned j = 0; j < 16; ++j) { const unsigned c = xb_ld(&bw[XB_XCNT(j)]); ok &= (c == (j < 8 ? (unsigned)F.G / 8u : 0u)) ? 1u : 0u; }
            F.MISC[12] = ok; }
        __syncthreads();
        if (F.MISC[12]) { const int x = (int)F.MISC[10], r = (int)F.MISC[11]; F.cid = __builtin_amdgcn_readfirstlane(r * 8 + x); F.vcu = __builtin_amdgcn_readfirstlane(x * (F.G / 8) + r); }
    }
    for (int l = 0; l < DEPTH; ++l) {
        const int pb = 1 + 8 * l; const bool cf = (F.cid & 1) != 0;
#define CONV(first, lyr, a, b) do { if ((first) == cf) { convert_jobs(F, lyr, a, b); if (first) __syncthreads(); } } while (0)
        if (IN(pb + 0)) { CONV(true, l, J_W2, J_QKV); ph_ffn_in(F, l, 0); CONV(false, l, J_W2, J_QKV); SEAM(pb + 0); }
        if (IN(pb + 1)) { CONV(true, l, J_QKV, J_A); ph_ffn_out(F, l, 0); CONV(false, l, J_QKV, J_A); SEAM(pb + 1); }
        if (IN(pb + 2)) { ph_qkvg(F, l); ph_gates(F, l); SEAM(pb + 2); }
        if (IN(pb + 3)) { CONV(true, l, J_A, J_O); attn_a(F, l); attn_b(F, l); attn_c(F, l); CONV(false, l, J_A, J_O); SEAM(pb + 3); }
        if (IN(pb + 4)) { CONV(true, l, J_O, J_W3); ph_branches(F, l); CONV(false, l, J_O, J_W3); SEAM(pb + 4); }
        if (IN(pb + 5)) { CONV(true, l, J_W3, J_W4); ph_wout(F, l); CONV(false, l, J_W3, J_W4); SEAM(pb + 5); }
        if (IN(pb + 6)) { CONV(true, l, J_W4, I_LAYER); ph_ffn_in(F, l, 1); CONV(false, l, J_W4, I_LAYER); SEAM(pb + 6); }
        if (IN(pb + 7)) { if (l + 1 < DEPTH) CONV(true, l + 1, J_W1, J_W2); ph_ffn_out(F, l, 1); if (l + 1 < DEPTH) CONV(false, l + 1, J_W1, J_W2); SEAM(pb + 7); }
#undef CONV
    }
    if (IN(NPH - 1)) final_norm(F);
#undef IN
#undef SEAM
}

extern "C" void kernel_launch(void* const* d_in, const int* in_sizes, int n_in, void* d_out, int out_size, void* d_ws, size_t ws_size, hipStream_t stream) {
    static int grid = 0;
    if (grid == 0) {
        if (n_in != 21 || in_sizes[0] != M * DM || out_size != M * DM || ws_size < WS_END) { fprintf(stderr, "kernel_launch: unexpected shapes (n_in %d, in0 %d, out %d, ws %zu < %zu); nothing launched\n", n_in, n_in > 0 ? in_sizes[0] : -1, out_size, ws_size, (size_t)WS_END); grid = -1; return; }
        int dev = 0, cus = 0, per_cu = 0;
        if (hipGetDevice(&dev) != hipSuccess || hipDeviceGetAttribute(&cus, hipDeviceAttributeMultiprocessorCount, dev) != hipSuccess) { grid = -1; return; }
        if (hipFuncSetAttribute((const void*)mk_fwd, hipFuncAttributeMaxDynamicSharedMemorySize, LDS_BYTES) != hipSuccess) { fprintf(stderr, "kernel_launch: hipFuncSetAttribute failed\n"); grid = -1; return; }
        if (hipOccupancyMaxActiveBlocksPerMultiprocessor(&per_cu, (const void*)mk_fwd, NWAVES * 64, LDS_BYTES) != hipSuccess || per_cu < 1) fprintf(stderr, "kernel_launch: occupancy query reports %d\n", per_cu);
        (void)hipGetLastError();
        grid = cus;
    }
    if (grid < 0) return;
    if (hipMemsetAsync((char*)d_ws + WS_CTL, 0, CTL_ZERO_BYTES, stream) != hipSuccess) { fprintf(stderr, "kernel_launch: hipMemsetAsync failed\n"); return; }
    Args a{};
    for (int i = 0; i < 21; ++i) a.in[i] = (const float*)d_in[i];
    a.out = (float*)d_out; a.ws = (unsigned char*)d_ws; a.pad = 0;
#if MK_PER_PHASE
    for (int p = 0; p < NPH; ++p) { a.ph_lo = p; a.ph_hi = p + 1; a.li = 0; hipLaunchKernelGGL(mk_fwd, dim3(grid), dim3(NWAVES * 64), LDS_BYTES, stream, a); }
#else
    a.ph_lo = 0; a.ph_hi = NPH; a.li = 0;
    hipLaunchKernelGGL(mk_fwd, dim3(grid), dim3(NWAVES * 64), LDS_BYTES, stream, a);
#endif
    const hipError_t le = hipPeekAtLastError();
    if (le != hipSuccess) fprintf(stderr, "kernel_launch: launch failed: %s\n", hipGetErrorName(le));
}
```

```cpp
#include <hip/hip_runtime.h>
#include <cstdio>
#include <cstdint>

#ifndef MK_PER_PHASE
#define MK_PER_PHASE 0
#endif

namespace pg8 {
#define PG8_LAS __attribute__((address_space(3)))
typedef unsigned short bf16_t;
typedef short bf16x8 __attribute__((ext_vector_type(8)));
typedef float f32x4 __attribute__((ext_vector_type(4)));
typedef unsigned u32x4 __attribute__((ext_vector_type(4)));
constexpr int BM = 256, BK = 64, HALF = 128, HTB = HALF * BK * 2  , STAGE_BYTES = 8 * HTB, NXCD = 8, WGM = 8;

__host__ __device__ __forceinline__ int lds_byte(int r, int c) { const int st = (r >> 4) * 2 + (c >> 5), rr = r & 15, cc = c & 31, ob = rr * 64 + cc * 2; return st * 1024 + (ob ^ (((ob >> 9) & 1) << 5)); }
__host__ __device__ __forceinline__ void stage_rc(int b, int& R, int& C) { const int st = b / 1024, sb = b % 1024, swz = sb ^ (((sb >> 9) & 1) << 5); R = (st >> 1) * 16 + swz / 64; C = (st & 1) * 32 + (swz % 64) / 2; }
__host__ __device__ __forceinline__ int perm32(int rho) { const int n = rho >> 4, i = rho & 15; return 8 * (i >> 2) + 4 * n + (i & 3); }

__device__ __forceinline__ int launder_v(int x) { asm volatile("" : "+v"(x)); return x; }
__device__ __forceinline__ int lane_id() { int x; asm volatile("v_mbcnt_lo_u32_b32 %0, -1, 0\n\tv_mbcnt_hi_u32_b32 %0, -1, %0" : "=v"(x)); return x; }
template <int O> __device__ __forceinline__ float xor_lt32(float v) { return __int_as_float(__builtin_amdgcn_ds_swizzle(__float_as_int(v), (O << 10) | 0x1f)); }
__device__ __forceinline__ float xor32(float v, int hi) { const auto rr = __builtin_amdgcn_permlane32_swap(__float_as_uint(v), __float_as_uint(v), false, false); return __uint_as_float(hi ? rr[0] : rr[1]); }
__device__ __forceinline__ float sum32(float v) { const auto rr = __builtin_amdgcn_permlane32_swap(__float_as_uint(v), __float_as_uint(v), false, false); return __uint_as_float(rr[0]) + __uint_as_float(rr[1]); }
__device__ __forceinline__ float max32(float v) { const auto rr = __builtin_amdgcn_permlane32_swap(__float_as_uint(v), __float_as_uint(v), false, false); return fmaxf(__uint_as_float(rr[0]), __uint_as_float(rr[1])); }
struct Unit { int pm, pn; };
struct Gemm { const bf16_t* A; const bf16_t* Bt; int M, N, K; };

struct StaticOrder {
    int nM, nN, nwg, G, c;
    __host__ __device__ void init(int M, int N, int G_, int c_) { nM = M / BM; nN = N / BM; nwg = nM * nN; G = G_; c = c_; }
    __host__ __device__ bool next(int i, Unit& u) const {
        const long L = (long)i * G + c; if (L >= nwg) return false;
        int wgid = (int)L; { const int q = nwg / NXCD, r = nwg % NXCD, xcd = wgid % NXCD, off = wgid / NXCD; wgid = (xcd < r ? xcd * (q + 1) : r * (q + 1) + (xcd - r) * q) + off; }
        const int nig = WGM * nN, gid = wgid / nig, fm = gid * WGM, gsz = (nM - fm) < WGM ? (nM - fm) : WGM;
        u.pm = fm + ((wgid % nig) % gsz); u.pn = (wgid % nig) / gsz;
        { const int rot = (c % NXCD) * (nN / NXCD); u.pn += rot; if (u.pn >= nN) u.pn -= nN; }
        return true;
    }
    __device__ __forceinline__ void a_ready(const Unit&) const {}
    __device__ __forceinline__ void done(const Unit&) const {}
};

typedef float f32x2_t __attribute__((ext_vector_type(2))); typedef __bf16 bf16x2_t __attribute__((ext_vector_type(2)));
__device__ __forceinline__ unsigned cvt_pk_bf16(float lo, float hi) { const f32x2_t v = {lo, hi}; const bf16x2_t b = __builtin_convertvector(v, bf16x2_t); return __builtin_bit_cast(unsigned, b); }
__device__ __forceinline__ u32x4 pack8(const f32x4 v0, const f32x4 v1) { u32x4 w; w.x = cvt_pk_bf16(v0[0], v0[1]); w.y = cvt_pk_bf16(v0[2], v0[3]); w.z = cvt_pk_bf16(v1[0], v1[1]); w.w = cvt_pk_bf16(v1[2], v1[3]); return w; }
__device__ __forceinline__ float bflo(unsigned w) { return __uint_as_float(w << 16); }
__device__ __forceinline__ float bfhi(unsigned w) { return __uint_as_float(w & 0xffff0000u); }
__device__ __forceinline__ float sigm(float x) { return __builtin_amdgcn_rcpf(1.0f + __builtin_amdgcn_exp2f(-1.44269504089f * x)); }
constexpr float SS_SCALE = 1048576.0f;
__device__ __forceinline__ float rstd_from(const unsigned long long* ss, int row, float eps) { return rsqrtf((float)ss[row] * (1.0f / (SS_SCALE * 4096.0f)) + eps); }
constexpr float RMS_EPS = 1e-6f;
struct RowScales { float rs[8]; int pm;
    __device__ __forceinline__ void load(const unsigned long long* ss, int pm_, int wid, int lane, float mul) { pm = pm_; const int row0 = pm_ * BM + (wid >> 2) * 64 + (lane & 15);
#pragma unroll
        for (int j = 0; j < 8; ++j) rs[j] = rstd_from(ss, row0 + (j >> 2) * HALF + (j & 3) * 16, RMS_EPS) * mul; }
    __device__ __forceinline__ float get(const unsigned long long* ss, const Unit& u, int ai, int m, int row, float mul) const { return u.pm == pm ? rs[ai * 4 + m] : rstd_from(ss, row, RMS_EPS) * mul; }
};

__device__ __forceinline__ unsigned pk4_fp8(float a, float b, float c, float d) { int w = 0; w = __builtin_amdgcn_cvt_pk_fp8_f32(a, b, w, false); w = __builtin_amdgcn_cvt_pk_fp8_f32(c, d, w, true); return (unsigned)w; }
template <bool H8> struct EpiSwigluT {
    static constexpr bool PERM = true, AFTER_DRAIN = false;
    bf16_t* H; const unsigned long long* ss; RowScales R; float mul;
    __device__ __forceinline__ void operator()(const f32x4 (&acc)[2][2][4][2], const Unit& u, int wr, int wc, int fr_, int fq_) const {
        const int fr = launder_v(fr_), fq = launder_v(fq_);
        const int row0 = u.pm * BM + wr * 64 + fr, col0 = u.pn * HALF + wc * 32 + 8 * fq;
#pragma unroll
        for (int ai = 0; ai < 2; ++ai)
#pragma unroll
            for (int m = 0; m < 4; ++m) { const int row = row0 + ai * HALF + m * 16; const float rs = R.get(ss, u, ai, m, row, mul), rl = rs * -1.44269504089f, iq = __builtin_amdgcn_rcpf(rs * rs);
                f32x4 h[2];
#pragma unroll
                for (int n = 0; n < 2; ++n)
#pragma unroll
                    for (int i = 0; i < 4; ++i) { const float ag = acc[ai][0][m][n][i]; h[n][i] = (ag * acc[ai][1][m][n][i]) * __builtin_amdgcn_rcpf(__builtin_fmaf(__builtin_amdgcn_exp2f(ag * rl), iq, iq)); }
                if constexpr (H8) { typedef unsigned u32x2 __attribute__((ext_vector_type(2))); u32x2 w8; w8.x = pk4_fp8(h[0][0], h[0][1], h[0][2], h[0][3]); w8.y = pk4_fp8(h[1][0], h[1][1], h[1][2], h[1][3]);
                    *(u32x2*)((unsigned char*)H + (size_t)row * 4096 + col0) = w8; }
                else *(u32x4*)(H + (size_t)row * 4096 + col0) = pack8(h[0], h[1]); }
    }
};
typedef EpiSwigluT<false> EpiSwiglu;
__device__ __forceinline__ void unpack8(const u32x4 w, f32x4& v0, f32x4& v1) { v0[0] = bflo(w.x); v0[1] = bfhi(w.x); v0[2] = bflo(w.y); v0[3] = bfhi(w.y); v1[0] = bflo(w.z); v1[1] = bfhi(w.z); v1[2] = bflo(w.w); v1[3] = bfhi(w.w); }
template <bool EMIT8> struct EpiResid {
    static constexpr bool PERM = true, AFTER_DRAIN = false;
    const float* base_f32; bf16_t* xb; unsigned long long* ss_out; float scale; long x8_delta;
    __device__ __forceinline__ void operator()(const f32x4 (&acc)[2][2][4][2], const Unit& u, int wr, int wc, int fr_, int fq_) const {
        const int fr = launder_v(fr_), fq = launder_v(fq_);
        const int row0 = u.pm * BM + wr * 64 + fr, col0 = u.pn * BM + wc * 32 + 8 * fq;
        if (base_f32) {
#pragma unroll
            for (int ai = 0; ai < 2; ++ai)
#pragma unroll
                for (int m = 0; m < 4; ++m) { const int row = row0 + ai * HALF + m * 16; float s = 0.f;
#pragma unroll
                    for (int bj = 0; bj < 2; ++bj) { const size_t off = (size_t)row * 4096 + col0 + bj * HALF;
                        const f32x4 b0 = *(const f32x4*)(base_f32 + off), b1 = *(const f32x4*)(base_f32 + off + 4);
                        const f32x4 v0 = b0 + acc[ai][bj][m][0] * scale, v1 = b1 + acc[ai][bj][m][1] * scale;
                        *(u32x4*)(xb + off) = pack8(v0, v1);
                        if constexpr (EMIT8) { typedef unsigned u32x2 __attribute__((ext_vector_type(2))); u32x2 w8; w8.x = pk4_fp8(v0[0], v0[1], v0[2], v0[3]); w8.y = pk4_fp8(v1[0], v1[1], v1[2], v1[3]); *(u32x2*)((unsigned char*)xb + x8_delta + off) = w8; }
                        s += (v0[0] * v0[0] + v0[1] * v0[1]) + (v0[2] * v0[2] + v0[3] * v0[3]) + (v1[0] * v1[0] + v1[1] * v1[1]) + (v1[2] * v1[2] + v1[3] * v1[3]); }
                    s += xor_lt32<16>(s); s = sum32(s);
                    if (fq == 0) atomicAdd(ss_out + row, (unsigned long long)(s * SS_SCALE + 0.5f));
                    if (m == 3) asm volatile("" ::: "memory"); }
            return;
        }
        u32x4 xr[2][4][2];
#define RES_LD(ai, m) do { _Pragma("unroll") for (int bj = 0; bj < 2; ++bj) xr[ai][m][bj] = *(const u32x4*)(xb + (size_t)(row0 + (ai) * HALF + (m) * 16) * 4096 + col0 + bj * HALF); } while (0)
        RES_LD(0, 0); RES_LD(0, 1); RES_LD(0, 2); RES_LD(0, 3); RES_LD(1, 0); RES_LD(1, 1);
        asm volatile("" ::: "memory");
#pragma unroll
        for (int ai = 0; ai < 2; ++ai)
#pragma unroll
            for (int m = 0; m < 4; ++m) { const int row = row0 + ai * HALF + m * 16; float s = 0.f;
#pragma unroll
                for (int bj = 0; bj < 2; ++bj) { const size_t off = (size_t)row * 4096 + col0 + bj * HALF;
                    f32x4 b0, b1; unpack8(xr[ai][m][bj], b0, b1);
                    const f32x4 v0 = b0 + acc[ai][bj][m][0] * scale, v1 = b1 + acc[ai][bj][m][1] * scale;
                    *(u32x4*)(xb + off) = pack8(v0, v1);
                    if constexpr (EMIT8) { typedef unsigned u32x2 __attribute__((ext_vector_type(2))); u32x2 w8; w8.x = pk4_fp8(v0[0], v0[1], v0[2], v0[3]); w8.y = pk4_fp8(v1[0], v1[1], v1[2], v1[3]); *(u32x2*)((unsigned char*)xb + x8_delta + off) = w8; }
                    s += (v0[0] * v0[0] + v0[1] * v0[1]) + (v0[2] * v0[2] + v0[3] * v0[3]) + (v1[0] * v1[0] + v1[1] * v1[1]) + (v1[2] * v1[2] + v1[3] * v1[3]); }
                s += xor_lt32<16>(s); s = sum32(s);
                if (fq == 0) atomicAdd(ss_out + row, (unsigned long long)(s * SS_SCALE + 0.5f));
                if (ai == 0 && m == 1) { asm volatile("" ::: "memory"); RES_LD(1, 2); RES_LD(1, 3); asm volatile("" ::: "memory"); } }
#undef RES_LD
    }
};
struct EpiQKVG {
    static constexpr bool PERM = true, AFTER_DRAIN = false;
    bf16_t* qkv; bf16_t* gates; const unsigned long long* ss; const float* cosA; const float* sinA; const float* cosC; const float* sinC; RowScales R;
    __device__ __forceinline__ void operator()(const f32x4 (&acc)[2][2][4][2], const Unit& u, int wr, int wc, int fr_, int fq_) const {
        const int fr = launder_v(fr_), fq = launder_v(fq_);
        constexpr size_t MM = 16384;
        const int row0 = u.pm * BM + wr * 64 + fr; const int pn = u.pn;
        bf16_t* const QA = qkv; bf16_t* const KA = QA + MM * 2048; bf16_t* const VA = KA + MM * 512; bf16_t* const QB = VA + MM * 512; bf16_t* const KB = QB + MM * 1024; bf16_t* const VB = KB + MM * 1024;
        bf16_t* const QC = VB + MM * 1024; bf16_t* const KC = QC + MM * 1024; bf16_t* const VC = KC + MM * 1024;
        constexpr float L2E = 1.44269504089f;
        if (pn >= 36) {
            const int col0 = (pn - 36) * BM + wc * 32 + 8 * fq;
#pragma unroll
            for (int ai = 0; ai < 2; ++ai)
#pragma unroll
                for (int m = 0; m < 4; ++m) { const int row = row0 + ai * HALF + m * 16; const float rs = rstd_from(ss, row, RMS_EPS);
#pragma unroll
                    for (int bj = 0; bj < 2; ++bj) { f32x4 v0, v1;
#pragma unroll
                        for (int i = 0; i < 4; ++i) { v0[i] = sigm(acc[ai][bj][m][0][i] * rs); v1[i] = sigm(acc[ai][bj][m][1][i] * rs); }
                        *(u32x4*)(gates + (size_t)row * 12288 + col0 + bj * HALF) = pack8(v0, v1); } }
        } else if (pn < 10 || (pn >= 24 && pn < 32)) {
            const bool isA = pn < 10;
            bf16_t* dst; int ld, hcol, idx0, half; const float* ct; const float* st; float sc;
            if (isA) { const bool q = pn < 8; const int t = q ? pn : pn - 8; dst = q ? QA : KA; ld = q ? 2048 : 512; hcol = (2 * t + (wc >> 1)) * 128; idx0 = 32 * (wc & 1) + 8 * fq; half = 64; ct = cosA; st = sinA; sc = q ? 0.08838834764831845f * L2E : 1.0f; }
            else { const bool q = pn < 28; const int t = (pn - 24) & 3; dst = q ? QC : KC; ld = 1024; hcol = (4 * t + wc) * 64; idx0 = 8 * fq; half = 32; ct = cosC; st = sinC; sc = q ? 0.125f * L2E : 1.0f; }
#pragma unroll
            for (int ai = 0; ai < 2; ++ai)
#pragma unroll
                for (int m = 0; m < 4; ++m) { const int row = row0 + ai * HALF + m * 16; const float rs = R.get(ss, u, ai, m, row, 1.0f); const int pos = row & 4095;
                    const float* cp = ct + (size_t)pos * half + idx0; const float* sp = st + (size_t)pos * half + idx0;
                    const f32x4 c0 = *(const f32x4*)cp, c1 = *(const f32x4*)(cp + 4), s0 = *(const f32x4*)sp, s1 = *(const f32x4*)(sp + 4);
                    const f32x4 a0 = acc[ai][0][m][0] * rs, a1 = acc[ai][0][m][1] * rs, b0 = acc[ai][1][m][0] * rs, b1 = acc[ai][1][m][1] * rs;
                    const f32x4 y10 = (a0 * c0 - b0 * s0) * sc, y11 = (a1 * c1 - b1 * s1) * sc, y20 = (b0 * c0 + a0 * s0) * sc, y21 = (b1 * c1 + a1 * s1) * sc;
                    bf16_t* rp = dst + (size_t)row * ld + hcol + idx0;
                    *(u32x4*)rp = pack8(y10, y11); *(u32x4*)(rp + half) = pack8(y20, y21); }
        } else {
            bf16_t* dst; int ld, t0; float sc = 1.0f;
            if (pn < 12) { dst = VA; ld = 512; t0 = 10; } else if (pn < 16) { dst = QB; ld = 1024; t0 = 12; sc = 0.08838834764831845f * L2E; } else if (pn < 20) { dst = KB; ld = 1024; t0 = 16; }
            else if (pn < 24) { dst = VB; ld = 1024; t0 = 20; } else { dst = VC; ld = 1024; t0 = 32; }
            const int col0 = (pn - t0) * BM + wc * 32 + 8 * fq;
#pragma unroll
            for (int ai = 0; ai < 2; ++ai)
#pragma unroll
                for (int m = 0; m < 4; ++m) { const int row = row0 + ai * HALF + m * 16; const float rs = R.get(ss, u, ai, m, row, 1.0f) * sc;
#pragma unroll
                    for (int bj = 0; bj < 2; ++bj) *(u32x4*)(dst + (size_t)row * ld + col0 + bj * HALF) = pack8(acc[ai][bj][m][0] * rs, acc[ai][bj][m][1] * rs); }
        }
    }
};
struct EpiGates {
    static constexpr bool PERM = true, AFTER_DRAIN = false;
    unsigned char* gates; const unsigned long long* ss; RowScales R;
    __device__ __forceinline__ void operator()(const f32x4 (&acc)[2][2][4][2], const Unit& u, int wr, int wc, int fr_, int fq_) const {
        const int fr = launder_v(fr_), fq = launder_v(fq_);
        const int row0 = u.pm * BM + wr * 64 + fr;
        u32x4* rec = (u32x4*)gates + ((size_t)(u.pm * 48 + u.pn) * 8 + (wr * 4 + wc)) * 8 * 64 + (fq * 16 + fr);
#pragma unroll
        for (int ai = 0; ai < 2; ++ai)
#pragma unroll
            for (int m = 0; m < 4; ++m) { const int row = row0 + ai * HALF + m * 16; const float rs = R.get(ss, u, ai, m, row, 1.0f / 64.0f) * -1.44269504089f;
                u32x4 w;
#pragma unroll
                for (int bj = 0; bj < 2; ++bj) { unsigned q[8];
#pragma unroll
                    for (int i = 0; i < 4; ++i) {
                        q[i] = __float_as_uint(__builtin_amdgcn_rcpf(__builtin_amdgcn_fmed3f(__builtin_fmaf(__builtin_amdgcn_exp2f(acc[ai][bj][m][0][i] * rs), 1.0f / 255.0f, 1.0f / 255.0f), 0.0f, 1.0f)) + 8388608.0f);
                        q[4 + i] = __float_as_uint(__builtin_amdgcn_rcpf(__builtin_amdgcn_fmed3f(__builtin_fmaf(__builtin_amdgcn_exp2f(acc[ai][bj][m][1][i] * rs), 1.0f / 255.0f, 1.0f / 255.0f), 0.0f, 1.0f)) + 8388608.0f); }
                    const unsigned lo = __builtin_amdgcn_perm(q[1], q[0], 0x0c0c0400u) | __builtin_amdgcn_perm(q[3], q[2], 0x04000c0cu), hi = __builtin_amdgcn_perm(q[5], q[4], 0x0c0c0400u) | __builtin_amdgcn_perm(q[7], q[6], 0x04000c0cu);
                    if (bj == 0) { w.x = lo; w.y = hi; } else { w.z = lo; w.w = hi; } }
                rec[(ai * 4 + m) * 64] = w; }
    }
};
struct EpiMerge {
    static constexpr bool PERM = true, AFTER_DRAIN = false;
    const unsigned char* gates; bf16_t* mb; int mode;
    __device__ __forceinline__ void operator()(const f32x4 (&acc)[2][2][4][2], const Unit& u, int wr, int wc, int fr_, int fq_) const {
        const int fr = launder_v(fr_), fq = launder_v(fq_);
        const int row0 = u.pm * BM + wr * 64 + fr, col0 = u.pn * BM + wc * 32 + 8 * fq;
#pragma unroll
        for (int ai = 0; ai < 2; ++ai)
#pragma unroll
            for (int m = 0; m < 4; ++m) { const int row = row0 + ai * HALF + m * 16;
#pragma unroll
                for (int bj = 0; bj < 2; ++bj) { const size_t off = (size_t)row * 4096 + col0 + bj * HALF;
                    typedef unsigned u32x2 __attribute__((ext_vector_type(2))); const u32x2 gw = *(const u32x2*)(gates + (size_t)row * 12288 + col0 + bj * HALF);
                    f32x4 v0, v1; v0[0] = (float)(gw.x & 0xffu); v0[1] = (float)((gw.x >> 8) & 0xffu); v0[2] = (float)((gw.x >> 16) & 0xffu); v0[3] = (float)(gw.x >> 24);
                    v1[0] = (float)(gw.y & 0xffu); v1[1] = (float)((gw.y >> 8) & 0xffu); v1[2] = (float)((gw.y >> 16) & 0xffu); v1[3] = (float)(gw.y >> 24);
                    v0 = v0 * acc[ai][bj][m][0] * (1.0f / 255.0f); v1 = v1 * acc[ai][bj][m][1] * (1.0f / 255.0f);
                    if (mode != 0) { f32x4 p0, p1; unpack8(*(const u32x4*)(mb + off), p0, p1); v0 = v0 + p0; v1 = v1 + p1; }
                    *(u32x4*)(mb + off) = pack8(v0, v1); }
                if (m == 3) asm volatile("" ::: "memory"); }
    }
};

typedef int v8i32 __attribute__((ext_vector_type(8))); typedef int v4i32 __attribute__((ext_vector_type(4)));
__device__ __forceinline__ v8i32 cat8(const bf16x8 lo, const bf16x8 hi) { const v4i32 a = __builtin_bit_cast(v4i32, lo), b = __builtin_bit_cast(v4i32, hi); return __builtin_shufflevector(a, b, 0, 1, 2, 3, 4, 5, 6, 7); }
template <class Epi, class Sched, bool ALIGN_EPI = false, bool SP2 = false, bool FP8 = false>
__device__ __forceinline__ void gemm_phase(PG8_LAS unsigned char* lds, const Gemm g, const Sched& S, const Epi& E, int wid) {
    const int lane = lane_id(), tid = wid * 64 + lane, wr = wid >> 2, wc = wid & 3, fr = lane & 15, fq = lane >> 4;
    const int K = g.K, nt = K / BK;
    unsigned voffA[2], voffB[2];
#pragma unroll
    for (int i = 0; i < 2; ++i) { int R, C; stage_rc(tid * 16 + i * 8192, R, C); const int Rb = Epi::PERM ? ((R & ~31) + perm32(R & 31)) : R;
        voffA[i] = (unsigned)(R * K + C) * 2u; voffB[i] = (unsigned)(Rb * K + C) * 2u; }
    const size_t kstep = (size_t)(BK * 2);
    const size_t hstep = (size_t)HALF * K * 2;
    const size_t tstep = 2 * hstep;
    const unsigned ldsw = (unsigned)wid * 1024u;
    const int aoff = lds_byte(wr * 64 + fr, fq * 8), boff = lds_byte(wc * 32 + fr, fq * 8);
#define PG8_SA(b, h) (((b) * 2 + (h)) * HTB)
#define PG8_SB(b, h) ((4 + (b) * 2 + (h)) * HTB)
#define PG8_STAGE(bufoff, gbase, voff) do { _Pragma("unroll") for (int _i = 0; _i < 2; ++_i) \
        __builtin_amdgcn_global_load_lds((const unsigned*)((const char*)(gbase) + (voff)[_i]), (PG8_LAS unsigned*)(lds + (bufoff) + ldsw + _i * 8192), 16, 0, 0); } while (0)
#define PG8_LDA(dst, b, h) do { _Pragma("unroll") for (int m = 0; m < 4; ++m) _Pragma("unroll") for (int k = 0; k < 2; ++k) dst[m][k] = *(const PG8_LAS bf16x8*)(lds + PG8_SA(b, h) + aoff + m * 2048 + k * 1024); } while (0)
#define PG8_LDB(dst, b, h) do { _Pragma("unroll") for (int n = 0; n < 2; ++n) _Pragma("unroll") for (int k = 0; k < 2; ++k) dst[n][k] = *(const PG8_LAS bf16x8*)(lds + PG8_SB(b, h) + boff + n * 2048 + k * 1024); } while (0)
#define PG8_MMA(ai, bj, At, Bt) do { __builtin_amdgcn_s_setprio(1); _Pragma("unroll") for (int m = 0; m < 4; ++m) _Pragma("unroll") for (int n = 0; n < 2; ++n) { \
        if constexpr (FP8) { asm volatile("s_nop 1\n\tv_mfma_scale_f32_16x16x128_f8f6f4 %0, %1, %2, %0, %3, %3 op_sel_hi:[0,0,0]" : "+v"(acc[ai][bj][m][n]) : "v"(cat8(Bt[n][0], Bt[n][1])), "v"(cat8(At[m][0], At[m][1])), "v"(0x7f7f7f7f)); } \
        else { _Pragma("unroll") for (int k = 0; k < 2; ++k) acc[ai][bj][m][n] = __builtin_amdgcn_mfma_f32_16x16x32_bf16(Bt[n][k], At[m][k], acc[ai][bj][m][n], 0, 0, 0); } } __builtin_amdgcn_s_setprio(0); } while (0)
#define PG8_WAIT_V(n) asm volatile("s_waitcnt vmcnt(" #n ")" ::: "memory")
#define PG8_WAIT_L(n) asm volatile("s_waitcnt lgkmcnt(" #n ")" ::: "memory")
#define PG8_BAR __builtin_amdgcn_s_barrier()
#define PG8_SCHED __builtin_amdgcn_sched_barrier(0)
    Unit cur, nxt; int ui = 0;
    if (!S.next(0, cur)) return;
    f32x4 acc[2][2][4][2];
#pragma unroll
    for (int a = 0; a < 2; ++a)
#pragma unroll
        for (int b = 0; b < 2; ++b)
#pragma unroll
            for (int m = 0; m < 4; ++m)
#pragma unroll
                for (int n = 0; n < 2; ++n) acc[a][b][m][n] = (f32x4){0.f, 0.f, 0.f, 0.f};
    bf16x8 At[4][2], B0[2][2], B1[2][2];
    const char* cA = (const char*)g.A + (size_t)cur.pm * tstep; const char* cB = (const char*)g.Bt + (size_t)cur.pn * tstep;
    S.a_ready(cur);
    if constexpr (SP2) {
        PG8_STAGE(PG8_SB(0, 0), cB, voffB); PG8_STAGE(PG8_SB(0, 1), cB + hstep, voffB); PG8_STAGE(PG8_SA(0, 0), cA, voffA); PG8_STAGE(PG8_SA(0, 1), cA + hstep, voffA);
        if (wr == 1) PG8_BAR;
        PG8_WAIT_V(2); PG8_BAR;
        PG8_STAGE(PG8_SB(1, 0), cB + kstep, voffB); PG8_STAGE(PG8_SA(1, 0), cA + kstep, voffA); PG8_STAGE(PG8_SB(1, 1), cB + hstep + kstep, voffB);
        PG8_WAIT_V(6); PG8_BAR;
    } else {
        PG8_STAGE(PG8_SB(0, 0), cB, voffB); PG8_STAGE(PG8_SA(0, 0), cA, voffA); PG8_STAGE(PG8_SB(0, 1), cB + hstep, voffB); PG8_STAGE(PG8_SA(0, 1), cA + hstep, voffA);
        if (wr == 1) PG8_BAR;
        PG8_WAIT_V(4); PG8_BAR;
        PG8_STAGE(PG8_SB(1, 0), cB + kstep, voffB); PG8_STAGE(PG8_SA(1, 0), cA + kstep, voffA); PG8_STAGE(PG8_SB(1, 1), cB + hstep + kstep, voffB);
        PG8_WAIT_V(6); PG8_BAR;
    }
    for (;;) {
        const bool has_next = S.next(ui + 1, nxt);
        const char* nA = has_next ? (const char*)g.A + (size_t)nxt.pm * tstep : cA; const char* nB = has_next ? (const char*)g.Bt + (size_t)nxt.pn * tstep : cB;
        for (int t = 0; t < nt; t += 2) {
            const bool last = (t == nt - 2);
            const char* a1 = cA + (size_t)(t + 1) * kstep;
            const char* a2 = last ? nA : cA + (size_t)(t + 2) * kstep; const char* b2 = last ? nB : cB + (size_t)(t + 2) * kstep;
            const char* a3 = a2 + kstep; const char* b3 = b2 + kstep;
            if (last && has_next) S.a_ready(nxt);
            if constexpr (SP2) {
            PG8_LDB(B0, 0, 0); PG8_LDB(B1, 0, 1); PG8_SCHED; PG8_LDA(At, 0, 0); PG8_STAGE(PG8_SA(1, 1), a1 + hstep, voffA);
            PG8_WAIT_V(8); PG8_WAIT_L(0); PG8_BAR; PG8_MMA(0, 0, At, B0); PG8_MMA(0, 1, At, B1); PG8_BAR; PG8_SCHED;
            PG8_LDA(At, 0, 1); PG8_STAGE(PG8_SB(0, 0), b2, voffB); PG8_STAGE(PG8_SB(0, 1), b2 + hstep, voffB); PG8_STAGE(PG8_SA(0, 0), a2, voffA);
            PG8_WAIT_V(8); PG8_WAIT_L(0); PG8_BAR; PG8_MMA(1, 0, At, B0); PG8_MMA(1, 1, At, B1); PG8_BAR; PG8_SCHED;
            PG8_LDB(B0, 1, 0); PG8_LDB(B1, 1, 1); PG8_SCHED; PG8_LDA(At, 1, 0); PG8_STAGE(PG8_SA(0, 1), a2 + hstep, voffA);
            PG8_WAIT_V(8); PG8_WAIT_L(0); PG8_BAR; PG8_MMA(0, 0, At, B0); PG8_MMA(0, 1, At, B1); PG8_BAR; PG8_SCHED;
            PG8_LDA(At, 1, 1); PG8_STAGE(PG8_SB(1, 0), b3, voffB); PG8_STAGE(PG8_SB(1, 1), b3 + hstep, voffB); PG8_STAGE(PG8_SA(1, 0), a3, voffA);
            PG8_WAIT_V(8); PG8_WAIT_L(0); PG8_BAR; PG8_MMA(1, 0, At, B0); PG8_MMA(1, 1, At, B1); PG8_BAR; PG8_SCHED;
            } else {
            PG8_LDB(B0, 0, 0); PG8_SCHED; PG8_LDA(At, 0, 0); PG8_STAGE(PG8_SA(1, 1), a1 + hstep, voffA);
            PG8_WAIT_L(8); PG8_BAR; PG8_WAIT_L(0); PG8_MMA(0, 0, At, B0); PG8_BAR; PG8_SCHED;
            PG8_LDB(B1, 0, 1); PG8_STAGE(PG8_SB(0, 0), b2, voffB);
            PG8_BAR; PG8_WAIT_L(0); PG8_MMA(0, 1, At, B1); PG8_BAR;
            PG8_LDA(At, 0, 1); PG8_STAGE(PG8_SA(0, 0), a2, voffA);
            PG8_BAR; PG8_WAIT_L(0); PG8_MMA(1, 0, At, B0); PG8_BAR; PG8_SCHED;
            PG8_STAGE(PG8_SB(0, 1), b2 + hstep, voffB);
            PG8_WAIT_V(6); PG8_BAR; PG8_MMA(1, 1, At, B1); PG8_BAR;
            PG8_LDB(B0, 1, 0); PG8_SCHED; PG8_LDA(At, 1, 0); PG8_STAGE(PG8_SA(0, 1), a2 + hstep, voffA);
            PG8_WAIT_L(8); PG8_BAR; PG8_WAIT_L(0); PG8_MMA(0, 0, At, B0); PG8_BAR; PG8_SCHED;
            PG8_LDB(B1, 1, 1); PG8_STAGE(PG8_SB(1, 0), b3, voffB);
            PG8_BAR; PG8_WAIT_L(0); PG8_MMA(0, 1, At, B1); PG8_BAR;
            PG8_LDA(At, 1, 1); PG8_STAGE(PG8_SA(1, 0), a3, voffA);
            PG8_BAR; PG8_WAIT_L(0); PG8_MMA(1, 0, At, B0); PG8_BAR; PG8_SCHED;
            PG8_STAGE(PG8_SB(1, 1), b3 + hstep, voffB);
            PG8_WAIT_V(6); PG8_BAR; PG8_MMA(1, 1, At, B1); PG8_BAR;
            }
        }
        if constexpr (ALIGN_EPI) { if (wr == 0) PG8_BAR; }
        if constexpr (FP8) asm volatile("s_nop 15\n\ts_nop 15" ::: "memory");
        if constexpr (!Epi::AFTER_DRAIN) { E(acc, cur, wr, wc, fr, fq); S.done(cur); }
        if (!has_next) break;
#pragma unroll
        for (int a = 0; a < 2; ++a)
#pragma unroll
            for (int b = 0; b < 2; ++b)
#pragma unroll
                for (int m = 0; m < 4; ++m)
#pragma unroll
                    for (int n = 0; n < 2; ++n) acc[a][b][m][n] = (f32x4){0.f, 0.f, 0.f, 0.f};
        cur = nxt; cA = nA; cB = nB; ++ui;
        if constexpr (ALIGN_EPI) { if (wr == 1) PG8_BAR; }
    }
    PG8_WAIT_V(0);
    if constexpr (!ALIGN_EPI) { if (wr == 0) PG8_BAR; }
    PG8_BAR;
#undef PG8_SA
#undef PG8_SB
#undef PG8_STAGE
#undef PG8_LDA
#undef PG8_LDB
#undef PG8_MMA
#undef PG8_WAIT_V
#undef PG8_WAIT_L
#undef PG8_BAR
#undef PG8_SCHED
}

struct MergeGemm { const bf16_t* Aa; const bf16_t* Abc; const bf16_t* Ba; const bf16_t* Bbc; const unsigned char* gates; bf16_t* mb; };
__device__ __forceinline__ void unpack_u8(const unsigned w, float (&f)[4]) { f[0] = (float)(w & 0xffu); f[1] = (float)((w >> 8) & 0xffu); f[2] = (float)((w >> 16) & 0xffu); f[3] = (float)(w >> 24); }
template <class Sched>
__device__ __forceinline__ void gemm_phase_merge(PG8_LAS unsigned char* lds, const MergeGemm g, const Sched& S, int wid) {
    constexpr int K = 2048;
    const int lane = lane_id(), tid = wid * 64 + lane, wr = wid >> 2, wc = wid & 3, fr = lane & 15, fq = lane >> 4;
    unsigned voffA[2], voffB[2];
#pragma unroll
    for (int i = 0; i < 2; ++i) { int R, C; stage_rc(tid * 16 + i * 8192, R, C); const int Rb = (R & ~31) + perm32(R & 31);
        voffA[i] = (unsigned)(R * K + C) * 2u; voffB[i] = (unsigned)(Rb * K + C) * 2u; }
    const size_t kstep = (size_t)(BK * 2);
    const size_t hstep = (size_t)HALF * K * 2;
    const size_t tstep = 2 * hstep;
    const unsigned ldsw = (unsigned)wid * 1024u;
    const int aoff = lds_byte(wr * 64 + fr, fq * 8), boff = lds_byte(wc * 32 + fr, fq * 8);
#define PG8_SA(b, h) (((b) * 2 + (h)) * HTB)
#define PG8_SB(b, h) ((4 + (b) * 2 + (h)) * HTB)
#define PG8_STAGE(bufoff, gbase, voff) do { _Pragma("unroll") for (int _i = 0; _i < 2; ++_i) \
        __builtin_amdgcn_global_load_lds((const unsigned*)((const char*)(gbase) + (voff)[_i]), (PG8_LAS unsigned*)(lds + (bufoff) + ldsw + _i * 8192), 16, 0, 0); } while (0)
#define PG8_LDA(dst, b, h) do { _Pragma("unroll") for (int m = 0; m < 4; ++m) _Pragma("unroll") for (int k = 0; k < 2; ++k) dst[m][k] = *(const PG8_LAS bf16x8*)(lds + PG8_SA(b, h) + aoff + m * 2048 + k * 1024); } while (0)
#define PG8_LDB(dst, b, h) do { _Pragma("unroll") for (int n = 0; n < 2; ++n) _Pragma("unroll") for (int k = 0; k < 2; ++k) dst[n][k] = *(const PG8_LAS bf16x8*)(lds + PG8_SB(b, h) + boff + n * 2048 + k * 1024); } while (0)
#define PG8_MMA(ai, bj, At, Bt) do { __builtin_amdgcn_s_setprio(1); _Pragma("unroll") for (int m = 0; m < 4; ++m) _Pragma("unroll") for (int n = 0; n < 2; ++n) _Pragma("unroll") for (int k = 0; k < 2; ++k) \
        acc[ai][bj][m][n] = __builtin_amdgcn_mfma_f32_16x16x32_bf16(Bt[n][k], At[m][k], acc[ai][bj][m][n], 0, 0, 0); __builtin_amdgcn_s_setprio(0); } while (0)
#define PG8_WAIT_V(n) asm volatile("s_waitcnt vmcnt(" #n ")" ::: "memory")
#define PG8_WAIT_L(n) asm volatile("s_waitcnt lgkmcnt(" #n ")" ::: "memory")
#define PG8_BAR __builtin_amdgcn_s_barrier()
#define PG8_SCHED __builtin_amdgcn_sched_barrier(0)
#define MG_A(pm, br) ((const char*)((br) == 0 ? g.Aa : g.Abc + ((br) == 2 ? 1024 : 0)) + (size_t)(pm) * tstep)
#define MG_B(pn, br) ((const char*)((br) == 0 ? g.Ba : g.Bbc + ((br) == 2 ? 1024 : 0)) + (size_t)(pn) * tstep)
    Unit cur, nu; int ui = 0, br = 0;
    if (!S.next(0, cur)) return;
    f32x4 acc[2][2][4][2];
#pragma unroll
    for (int a = 0; a < 2; ++a)
#pragma unroll
        for (int b = 0; b < 2; ++b)
#pragma unroll
            for (int m = 0; m < 4; ++m)
#pragma unroll
                for (int n = 0; n < 2; ++n) acc[a][b][m][n] = (f32x4){0.f, 0.f, 0.f, 0.f};
    bf16x8 At[4][2], B0[2][2], B1[2][2];
    const char* cA = MG_A(cur.pm, 0); const char* cB = MG_B(cur.pn, 0);
    PG8_STAGE(PG8_SB(0, 0), cB, voffB); PG8_STAGE(PG8_SB(0, 1), cB + hstep, voffB); PG8_STAGE(PG8_SA(0, 0), cA, voffA); PG8_STAGE(PG8_SA(0, 1), cA + hstep, voffA);
    if (wr == 1) PG8_BAR;
    PG8_WAIT_V(2); PG8_BAR;
    PG8_STAGE(PG8_SB(1, 0), cB + kstep, voffB); PG8_STAGE(PG8_SA(1, 0), cA + kstep, voffA); PG8_STAGE(PG8_SB(1, 1), cB + hstep + kstep, voffB);
    PG8_WAIT_V(6); PG8_BAR;
    for (;;) {
        int nbr = br + 1; bool has_next = true; nu = cur;
        if (nbr == 3) { nbr = 0; has_next = S.next(ui + 1, nu); }
        const char* nA = has_next ? MG_A(nu.pm, nbr) : cA; const char* nB = has_next ? MG_B(nu.pn, nbr) : cB;
        const int nt = br == 0 ? 32 : 16;
        for (int t = 0; t < nt; t += 2) {
            const bool last = (t == nt - 2);
            const char* a1 = cA + (size_t)(t + 1) * kstep;
            const char* a2 = last ? nA : cA + (size_t)(t + 2) * kstep; const char* b2 = last ? nB : cB + (size_t)(t + 2) * kstep;
            const char* a3 = a2 + kstep; const char* b3 = b2 + kstep;
            PG8_LDB(B0, 0, 0); PG8_LDB(B1, 0, 1); PG8_SCHED; PG8_LDA(At, 0, 0); PG8_STAGE(PG8_SA(1, 1), a1 + hstep, voffA);
            PG8_WAIT_V(8); PG8_WAIT_L(0); PG8_BAR; PG8_MMA(0, 0, At, B0); PG8_MMA(0, 1, At, B1); PG8_BAR; PG8_SCHED;
            PG8_LDA(At, 0, 1); PG8_STAGE(PG8_SB(0, 0), b2, voffB); PG8_STAGE(PG8_SB(0, 1), b2 + hstep, voffB); PG8_STAGE(PG8_SA(0, 0), a2, voffA);
            PG8_WAIT_V(8); PG8_WAIT_L(0); PG8_BAR; PG8_MMA(1, 0, At, B0); PG8_MMA(1, 1, At, B1); PG8_BAR; PG8_SCHED;
            PG8_LDB(B0, 1, 0); PG8_LDB(B1, 1, 1); PG8_SCHED; PG8_LDA(At, 1, 0); PG8_STAGE(PG8_SA(0, 1), a2 + hstep, voffA);
            PG8_WAIT_V(8); PG8_WAIT_L(0); PG8_BAR; PG8_MMA(0, 0, At, B0); PG8_MMA(0, 1, At, B1); PG8_BAR; PG8_SCHED;
            PG8_LDA(At, 1, 1); PG8_STAGE(PG8_SB(1, 0), b3, voffB); PG8_STAGE(PG8_SB(1, 1), b3 + hstep, voffB); PG8_STAGE(PG8_SA(1, 0), a3, voffA);
            PG8_WAIT_V(8); PG8_WAIT_L(0); PG8_BAR; PG8_MMA(1, 0, At, B0); PG8_MMA(1, 1, At, B1); PG8_BAR; PG8_SCHED;
        }
        if (wr == 0) PG8_BAR;
        {
            const int fr2 = launder_v(fr), fq2 = launder_v(fq);
            const int row0 = cur.pm * BM + wr * 64 + fr2, col0 = cur.pn * BM + wc * 32 + 8 * fq2;
            const u32x4* rec = (const u32x4*)g.gates + ((size_t)(cur.pm * 48 + br * 16 + cur.pn) * 8 + wid) * 8 * 64 + (fq2 * 16 + fr2);
#pragma unroll
            for (int ai = 0; ai < 2; ++ai)
#pragma unroll
                for (int m = 0; m < 4; ++m) { const int row = row0 + ai * HALF + m * 16;
                    const u32x4 gc = rec[(ai * 4 + m) * 64];
                    if (br < 2) {
                        const u32x4 gn = rec[(size_t)16 * 8 * 8 * 64 + (ai * 4 + m) * 64];
#pragma unroll
                        for (int bj = 0; bj < 2; ++bj) { float c0[4], c1[4], n0[4], n1[4]; unpack_u8(bj ? gc.z : gc.x, c0); unpack_u8(bj ? gc.w : gc.y, c1); unpack_u8(bj ? gn.z : gn.x, n0); unpack_u8(bj ? gn.w : gn.y, n1);
#pragma unroll
                            for (int i = 0; i < 4; ++i) { acc[ai][bj][m][0][i] *= c0[i] * __builtin_amdgcn_rcpf(n0[i]); acc[ai][bj][m][1][i] *= c1[i] * __builtin_amdgcn_rcpf(n1[i]); } }
                    } else {
#pragma unroll
                        for (int bj = 0; bj < 2; ++bj) { float c0[4], c1[4]; unpack_u8(bj ? gc.z : gc.x, c0); unpack_u8(bj ? gc.w : gc.y, c1);
                            f32x4 v0, v1;
#pragma unroll
                            for (int i = 0; i < 4; ++i) { v0[i] = acc[ai][bj][m][0][i] * (c0[i] * (1.0f / 255.0f)); v1[i] = acc[ai][bj][m][1][i] * (c1[i] * (1.0f / 255.0f)); }
                            *(u32x4*)(g.mb + (size_t)row * 4096 + col0 + bj * HALF) = pack8(v0, v1); } }
                    if (m == 3) asm volatile("" ::: "memory"); }
        }
        if (!has_next) break;
        if (br == 2) {
#pragma unroll
            for (int a = 0; a < 2; ++a)
#pragma unroll
                for (int b = 0; b < 2; ++b)
#pragma unroll
                    for (int m = 0; m < 4; ++m)
#pragma unroll
                        for (int n = 0; n < 2; ++n) acc[a][b][m][n] = (f32x4){0.f, 0.f, 0.f, 0.f};
            ++ui; }
        cur = nu; br = nbr; cA = nA; cB = nB;
        if (wr == 1) PG8_BAR;
    }
    PG8_WAIT_V(0);
    PG8_BAR;
#undef MG_A
#undef MG_B
#undef PG8_SA
#undef PG8_SB
#undef PG8_STAGE
#undef PG8_LDA
#undef PG8_LDB
#undef PG8_MMA
#undef PG8_WAIT_V
#undef PG8_WAIT_L
#undef PG8_BAR
#undef PG8_SCHED
}
}

constexpr int NWAVES = 8;
constexpr int DM = 4096, SEQ = 4096, NBATCH = 4, DEPTH = 4, DFF = 4096;
constexpr int M = NBATCH * SEQ;
constexpr int NQKV = 9216, NGATE = 12288, NQG = NQKV + NGATE;
constexpr int NPH = 2 + 8 * DEPTH;

constexpr size_t MiB = 1u << 20;
constexpr size_t WS_CTL = 0, CTL_ZERO_BYTES = 4 * MiB;
constexpr int CW_TICKET = 8192;
constexpr int CW_BAR = 16384;
constexpr size_t WS_SS = 1 * MiB;
constexpr size_t WS_ROPE = 4 * MiB;
constexpr size_t WS_W = 8 * MiB, W_LAYER = 424 * MiB;
constexpr size_t WO_W1 = 0, WO_W2 = 64 * MiB, WO_QG = 96 * MiB, WO_A = 264 * MiB, WO_B = 280 * MiB, WO_C = 288 * MiB, WO_O = 296 * MiB, WO_W3 = 328 * MiB, WO_W4 = 392 * MiB;
constexpr size_t WS_XF = WS_W + 4 * W_LAYER;
constexpr size_t WS_WG8 = WS_XF, WG8_LAYER = 48 * MiB;
constexpr size_t WS_XB8 = WS_XF + 192 * MiB;
constexpr size_t WS_XB = WS_XF + 256 * MiB;
constexpr size_t WS_HID = WS_XB + 128 * MiB;
constexpr size_t WS_QKV = WS_HID + 128 * MiB;
constexpr size_t WS_GATES = WS_QKV + 288 * MiB;
constexpr size_t WS_OA = WS_GATES + 384 * MiB;
constexpr size_t WS_MERGED = WS_OA + 128 * MiB, WS_W3F8 = WS_MERGED, WS_W4F8 = WS_MERGED + 32 * MiB;
#define FFN2_FP8(l) ((l) == 3)
constexpr size_t WS_MB = WS_MERGED + 256 * MiB;
constexpr size_t WS_END = WS_MB + 128 * MiB;

constexpr int RING_OFF = 0, RING_BYTES = 131072;
constexpr int LDSCTL_OFF = RING_BYTES, MISC_OFF = LDSCTL_OFF + 320;
constexpr int LDS_BYTES = 147456;
static_assert(MISC_OFF + 128 <= LDS_BYTES, "LDS map");

#define GAS __attribute__((address_space(1)))
#define LAS __attribute__((address_space(3)))
typedef unsigned short bf16;
typedef unsigned v4u __attribute__((ext_vector_type(4)));
typedef float f32x4 __attribute__((ext_vector_type(4)));
typedef GAS unsigned gu32;
#define RLX_AGENT __ATOMIC_RELAXED, __HIP_MEMORY_SCOPE_AGENT
#define LDS_WAIT() asm volatile("s_waitcnt lgkmcnt(0)" ::: "memory")
#define VM_WAIT() asm volatile("s_waitcnt vmcnt(0)" ::: "memory")
__device__ __forceinline__ unsigned f2bf(float f) { unsigned u = __builtin_bit_cast(unsigned, f); return (u + 0x7fffu + ((u >> 16) & 1u)) >> 16; }
__device__ __forceinline__ unsigned pk2(float lo, float hi) { return f2bf(lo) | (f2bf(hi) << 16); }
__device__ __forceinline__ float bf_lo(unsigned w) { return __uint_as_float(w << 16); }
__device__ __forceinline__ float bf_hi(unsigned w) { return __uint_as_float(w & 0xffff0000u); }

#define XB_TMO      128
#define XB_XCNT(j)  (256  + 64 * (j))
#define XB_XSUB(j)  (1280 + 64 * (j))
#define XB_XGEN(j)  (2304 + 64 * (j))
#define XB_TOP      3328
#define XB_TOPGEN   3392
#define XCD_BAR_WORDS 3456
#define XB_SPIN_CAP (1u << 22)

__device__ __forceinline__ unsigned xb_ld(unsigned* p)              { return __hip_atomic_load(p, __ATOMIC_RELAXED, __HIP_MEMORY_SCOPE_AGENT); }
__device__ __forceinline__ unsigned xb_add(unsigned* p, unsigned v) { return __hip_atomic_fetch_add(p, v, __ATOMIC_RELAXED, __HIP_MEMORY_SCOPE_AGENT); }
__device__ __forceinline__ unsigned xb_xcc_id() { return (unsigned)__builtin_amdgcn_readfirstlane((int)((unsigned)__builtin_amdgcn_s_getreg((3 << 11) | 20) & 0xFu)); }
#define XB_SPIN(cond, bar) do { unsigned _sp = 0; while (cond) { __builtin_amdgcn_s_sleep(1); \
    if ((++_sp & 255u) == 0u) { if (xb_ld(&(bar)[XB_TMO])) break; if (_sp > XB_SPIN_CAP) { atomicAdd(&(bar)[XB_TMO], 1u); break; } } } } while (0)

struct XcdBarrier {
    unsigned* bar; unsigned x;
    volatile LAS unsigned* st;
};
__device__ __forceinline__ XcdBarrier xcd_barrier_post(unsigned* bar, volatile LAS unsigned* st) {
    XcdBarrier b; b.bar = bar; b.x = xb_xcc_id(); b.st = st;
    if (threadIdx.x == 0) (void)xb_add(&bar[XB_XCNT(b.x)], 1u);
    return b;
}
__device__ __forceinline__ void xcd_barrier_complete(unsigned* bar, unsigned x, unsigned& nloc, unsigned& nx) {
    const unsigned G = gridDim.x * gridDim.y * gridDim.z;
    unsigned sum, cnt, mine, sp = 0u;
    for (;;) {
        sum = 0u; cnt = 0u; mine = 0u;
#pragma unroll
        for (unsigned j = 0; j < 16; ++j) { const unsigned c = xb_ld(&bar[XB_XCNT(j)]); sum += c; cnt += (c > 0u) ? 1u : 0u; mine = (j == x) ? c : mine; }
        if (sum == G) break;
        __builtin_amdgcn_s_sleep(1);
        if ((++sp & 255u) == 0u) { if (xb_ld(&bar[XB_TMO])) break; if (sp > XB_SPIN_CAP) { atomicAdd(&bar[XB_TMO], 1u); break; } }
    }
    nloc = mine > 0u ? mine : 1u; nx = cnt > 0u ? cnt : 1u;
}
__device__ __forceinline__ void xcd_barrier(const XcdBarrier& b, int wave) {
    asm volatile("s_waitcnt vmcnt(0)" ::: "memory");
    __syncthreads();
    if (wave == 0 && pg8::lane_id() == 0) {
        unsigned* bar = b.bar; unsigned bx = b.x; asm volatile("" : "+s"(bx));
        __builtin_amdgcn_s_waitcnt(0);
        unsigned nloc = b.st[0], nx = b.st[1];
        if (nloc == 0u) { xcd_barrier_complete(bar, bx, nloc, nx); b.st[0] = nloc; b.st[1] = nx; }
        const unsigned old = xb_add(&bar[XB_XSUB(bx)], 1u);
        const unsigned gen = old / nloc;
        if (old + 1u == (gen + 1u) * nloc) {
            __builtin_amdgcn_fence(__ATOMIC_RELEASE, "agent");
            asm volatile("s_waitcnt vmcnt(0)" ::: "memory");
            const unsigned og = xb_add(&bar[XB_TOP], 1u);
            const unsigned tg = og / nx;
            if (og + 1u == (tg + 1u) * nx) xb_add(&bar[XB_TOPGEN], 1u);
            else XB_SPIN(xb_ld(&bar[XB_TOPGEN]) == tg, bar);
            __builtin_amdgcn_fence(__ATOMIC_ACQUIRE, "agent");
            xb_add(&bar[XB_XGEN(bx)], 1u);
            asm volatile("s_waitcnt vmcnt(0)" ::: "memory");
        } else {
            XB_SPIN(xb_ld(&bar[XB_XGEN(bx)]) == gen, bar);
            __builtin_amdgcn_fence(__ATOMIC_ACQUIRE, "agent");
            asm volatile("s_waitcnt vmcnt(0)" ::: "memory");
        }
    }
    __syncthreads();
}

struct Args { const float* in[21]; float* out; unsigned char* ws; int ph_lo, ph_hi, li, pad; };
struct Frame {
    LAS unsigned char* lds;
    volatile LAS unsigned* MISC;
    gu32* ctl;
    int wave;
    int vcu, G;
    int cid;
    unsigned char* ws;
    float* out;
};
__device__ __forceinline__ const float* inp(int i) {
    unsigned off = (unsigned)i * 8u; asm volatile("" : "+s"(off));
    const __attribute__((address_space(4))) char* ka = (const __attribute__((address_space(4))) char*)__builtin_amdgcn_kernarg_segment_ptr();
    return *(const float* const __attribute__((address_space(4)))*)(ka + off);
}
__device__ __forceinline__ unsigned char* launder_p(unsigned char* p) { asm volatile("" : "+s"(p)); return p; }
__device__ __forceinline__ int launder_i(int x) { asm volatile("" : "+s"(x)); return x; }
__device__ __forceinline__ bf16* wgt(unsigned char* ws, int l, size_t off) { return (bf16*)(ws + WS_W + (size_t)l * W_LAYER + off); }
__device__ __forceinline__ unsigned long long* ssbuf(unsigned char* ws, int idx) { return (unsigned long long*)(ws + WS_SS) + (size_t)idx * M; }

__device__ __forceinline__ float wave_sum(float v) {
    v += pg8::xor_lt32<1>(v); v += pg8::xor_lt32<2>(v); v += pg8::xor_lt32<4>(v); v += pg8::xor_lt32<8>(v); v += pg8::xor_lt32<16>(v); return pg8::sum32(v);
}
__device__ __forceinline__ float wave_max(float v) {
    v = fmaxf(v, pg8::xor_lt32<1>(v)); v = fmaxf(v, pg8::xor_lt32<2>(v)); v = fmaxf(v, pg8::xor_lt32<4>(v)); v = fmaxf(v, pg8::xor_lt32<8>(v)); v = fmaxf(v, pg8::xor_lt32<16>(v)); return pg8::max32(v);
}

__device__ const float kInvFreq[64] = {
    1.000000000e+00f, 8.659643531e-01f, 7.498942018e-01f, 6.493816376e-01f, 5.623413324e-01f, 4.869675338e-01f, 4.216965139e-01f, 3.651741147e-01f, 3.162277639e-01f, 2.738419771e-01f, 2.371373922e-01f, 2.053525001e-01f, 1.778279394e-01f, 1.539926529e-01f, 1.333521456e-01f, 1.154782027e-01f,
    1.000000015e-01f, 8.659642935e-02f, 7.498941571e-02f, 6.493816525e-02f, 5.623412877e-02f, 4.869675264e-02f, 4.216964915e-02f, 3.651741147e-02f, 3.162277862e-02f, 2.738419734e-02f, 2.371373586e-02f, 2.053524926e-02f, 1.778279431e-02f, 1.539926510e-02f, 1.333521493e-02f, 1.154781971e-02f,
    9.999999776e-03f, 8.659643121e-03f, 7.498942316e-03f, 6.493816618e-03f, 5.623413250e-03f, 4.869675264e-03f, 4.216964822e-03f, 3.651741426e-03f, 3.162277862e-03f, 2.738419687e-03f, 2.371373819e-03f, 2.053525066e-03f, 1.778279431e-03f, 1.539926627e-03f, 1.333521446e-03f, 1.154781901e-03f,
    1.000000047e-03f, 8.659643354e-04f, 7.498941850e-04f, 6.493816618e-04f, 5.623413017e-04f, 4.869675031e-04f, 4.216965463e-04f, 3.651741135e-04f, 3.162277862e-04f, 2.738419571e-04f, 2.371373848e-04f, 2.053525241e-04f, 1.778279402e-04f, 1.539926452e-04f, 1.333521504e-04f, 1.154782076e-04f };

__device__ __forceinline__ void conv_item(const float* W, int ldw, int src_col0, int k0, const float* gain, bf16* dst, int K, int dst_row0, LAS float* scr, int lane) {
    const int kq = lane >> 3, n4 = (lane & 7) * 4;
    f32x4 v[8];
#pragma unroll
    for (int i = 0; i < 8; ++i) v[i] = __builtin_nontemporal_load((const GAS f32x4*)(W + (size_t)(k0 + kq + 8 * i) * ldw + src_col0 + n4));
    if (gain) {
#pragma unroll
        for (int i = 0; i < 8; ++i) v[i] = v[i] * gain[k0 + kq + 8 * i];
    }
#pragma unroll
    for (int i = 0; i < 8; ++i) { LAS float* s = scr + (kq + 8 * i) * 33 + n4; s[0] = v[i][0]; s[1] = v[i][1]; s[2] = v[i][2]; s[3] = v[i][3]; }
    LDS_WAIT(); asm volatile("" ::: "memory");
    const int c = lane & 7;
#pragma unroll
    for (int j = 0; j < 4; ++j) { const int n = (lane >> 3) + 8 * j; const LAS float* s = scr + (8 * c) * 33 + n;
        v4u o; o.x = pk2(s[0 * 33], s[1 * 33]); o.y = pk2(s[2 * 33], s[3 * 33]); o.z = pk2(s[4 * 33], s[5 * 33]); o.w = pk2(s[6 * 33], s[7 * 33]);
        __builtin_nontemporal_store(o, (GAS v4u*)(dst + (size_t)(dst_row0 + n) * K + k0 + 8 * c)); }
    LDS_WAIT(); asm volatile("" ::: "memory");
}
__device__ __forceinline__ void conv_item_fp8(const float* W, int ldw, int src_col0, int k0, const float* gain, float mul, unsigned char* dst8, int K, int dst_row0, LAS float* scr, int lane) {
    const int kq = lane >> 3, n4 = (lane & 7) * 4;
    f32x4 v[8];
#pragma unroll
    for (int i = 0; i < 8; ++i) v[i] = __builtin_nontemporal_load((const GAS f32x4*)(W + (size_t)(k0 + kq + 8 * i) * ldw + src_col0 + n4));
#pragma unroll
    for (int i = 0; i < 8; ++i) v[i] = v[i] * (gain ? gain[k0 + kq + 8 * i] * mul : mul);
#pragma unroll
    for (int i = 0; i < 8; ++i) { LAS float* s = scr + (kq + 8 * i) * 33 + n4; s[0] = v[i][0]; s[1] = v[i][1]; s[2] = v[i][2]; s[3] = v[i][3]; }
    LDS_WAIT(); asm volatile("" ::: "memory");
    const int c = lane & 7;
#pragma unroll
    for (int j = 0; j < 4; ++j) { const int n = (lane >> 3) + 8 * j; const LAS float* s = scr + (8 * c) * 33 + n;
        typedef unsigned u32x2 __attribute__((ext_vector_type(2))); u32x2 o; o.x = pg8::pk4_fp8(s[0 * 33], s[1 * 33], s[2 * 33], s[3 * 33]); o.y = pg8::pk4_fp8(s[4 * 33], s[5 * 33], s[6 * 33], s[7 * 33]);
        __builtin_nontemporal_store(o, (GAS u32x2*)(dst8 + (size_t)(dst_row0 + n) * K + k0 + 8 * c)); }
    LDS_WAIT(); asm volatile("" ::: "memory");
}
__device__ __forceinline__ int qkv_src_col(int n) {
    if (n < 2560) { const int base = n < 2048 ? 0 : 2048, nn = n - base, t = nn >> 8, r = nn & 255, hf = r >> 7, j = r & 127; return base + (2 * t + (j >> 6)) * 128 + hf * 64 + (j & 63); }
    if (n >= 6144 && n < 8192) { const int base = n < 7168 ? 6144 : 7168, nn = n - base, t = nn >> 8, r = nn & 255, hf = r >> 7, j = r & 127; return base + (4 * t + (j >> 5)) * 64 + hf * 32 + (j & 31); }
    return n;
}
__device__ __forceinline__ int ffn_src_col(int n) { const int t = n >> 8, r = n & 255; return (r < 128) ? (128 * t + r) : (4096 + 128 * t + (r - 128)); }

constexpr int I_W1 = (DM / 64) * (2 * DFF / 32), I_W2 = (DFF / 64) * (DM / 32), I_QKV = (DM / 64) * (NQKV / 32), I_G = (DM / 64) * (NGATE / 32), I_A = (2048 / 64) * (DM / 32), I_B = (1024 / 64) * (DM / 32), I_O = (DM / 64) * (DM / 32);
constexpr int J_W1 = 0, J_W2 = J_W1 + I_W1, J_QKV = J_W2 + I_W2, J_G = J_QKV + I_QKV, J_A = J_G + I_G, J_B = J_A + I_A, J_C = J_B + I_B, J_O = J_C + I_B, J_W3 = J_O + I_O, J_W4 = J_W3 + I_W1, I_LAYER = J_W4 + I_W2;
__device__ __forceinline__ void convert_jobs(Frame& F, int l, int r0, int r1) {
    unsigned char* const ws = launder_p(F.ws);
    const int lane = pg8::lane_id();
    LAS float* scr = (LAS float*)(F.lds + RING_OFF + F.wave * 16384);
    const int gw = F.cid * NWAVES + F.wave, NGW = F.G * NWAVES;
    for (int rr = r0 + gw; rr < r1; rr += NGW) {
        int r = rr;
        const float* W; int ldw, K, N, kind; const float* gain = nullptr; bf16* dst; int drow = 0;
        if (r < I_W1) { W = inp(2) + (size_t)l * DM * 2 * DFF; ldw = 2 * DFF; K = DM; N = 2 * DFF; kind = 1; gain = inp(1) + l * DM; dst = wgt(ws, l, WO_W1); }
        else if ((r -= I_W1) < I_W2) { W = inp(3) + (size_t)l * DFF * DM; ldw = DM; K = DFF; N = DM; kind = 0; dst = wgt(ws, l, WO_W2); }
        else if ((r -= I_W2) < I_QKV) { W = inp(5) + (size_t)l * DM * NQKV; ldw = NQKV; K = DM; N = NQKV; kind = 2; gain = inp(4) + l * DM; dst = wgt(ws, l, WO_QG); }
        else if ((r -= I_QKV) < I_G) { W = inp(6) + (size_t)l * DM * NGATE; ldw = NGATE; K = DM; N = NGATE; kind = 3; gain = inp(4) + l * DM; dst = nullptr; }
        else if ((r -= I_G) < I_A) { W = inp(13) + (size_t)l * 2048 * DM; ldw = DM; K = 2048; N = DM; kind = 0; dst = wgt(ws, l, WO_A); }
        else if ((r -= I_A) < I_B) { W = inp(14) + (size_t)l * 1024 * DM; ldw = DM; K = 2048; N = DM; kind = 0; dst = wgt(ws, l, WO_B); }
        else if ((r -= I_B) < I_B) { W = inp(15) + (size_t)l * 1024 * DM; ldw = DM; K = 2048; N = DM; kind = 0; dst = wgt(ws, l, WO_B) + 1024; }
        else if ((r -= I_B) < I_O) { W = inp(16) + (size_t)l * DM * DM; ldw = DM; K = DM; N = DM; kind = 0; dst = wgt(ws, l, WO_O); }
        else if ((r -= I_O) < I_W1) { W = inp(18) + (size_t)l * DM * 2 * DFF; ldw = 2 * DFF; K = DM; N = 2 * DFF; kind = FFN2_FP8(l) ? 4 : 1; gain = inp(17) + l * DM; dst = wgt(ws, l, WO_W3); }
        else { r -= I_W1; W = inp(19) + (size_t)l * DFF * DM; ldw = DM; K = DFF; N = DM; kind = FFN2_FP8(l) ? 5 : 0; dst = wgt(ws, l, WO_W4); }
        const int nblk = N / 32, kb = r / nblk, nb = r - kb * nblk, n0 = 32 * nb;
        const int sc = kind == 1 ? ffn_src_col(n0) : (kind == 2 ? qkv_src_col(n0) : n0);
        if (kind == 3) conv_item_fp8(W, ldw, n0, 64 * kb, gain, 64.0f, ws + WS_WG8 + (size_t)l * WG8_LAYER, K, n0, scr, lane);
        else if (kind == 4) conv_item_fp8(W, ldw, ffn_src_col(n0), 64 * kb, gain, 64.0f, ws + WS_W3F8, K, n0, scr, lane);
        else if (kind == 5) conv_item_fp8(W, ldw, n0, 64 * kb, nullptr, 64.0f, ws + WS_W4F8, K, n0, scr, lane);
        else conv_item(W, ldw, sc, 64 * kb, gain, dst, K, drow + n0, scr, lane);
    }
}
__device__ __forceinline__ void p0_prologue(Frame& F) {
    unsigned char* const ws = launder_p(F.ws);
    const int lane = pg8::lane_id();
    const int gw = F.vcu * NWAVES + F.wave, NGW = F.G * NWAVES;
    {
        float* cosA = (float*)(ws + WS_ROPE); float* sinA = cosA + 4096 * 64; float* cosC = sinA + 4096 * 64; float* sinC = cosC + 4096 * 32;
        const int gt = gw * 64 + lane, NGT = NGW * 64;
        for (int i = gt; i < 4096 * 96; i += NGT) {
            const bool isA = i < 4096 * 64; const int j = isA ? i : i - 4096 * 64; const int pos = isA ? (j >> 6) : (j >> 5), k = isA ? (j & 63) : (j & 31);
            const float inv = kInvFreq[isA ? k : 2 * k]; const float ang = (float)pos * inv;
            const double rev = (double)ang * 0.15915494309189535; const float fr = (float)(rev - floor(rev));
            const float c = __builtin_amdgcn_cosf(fr), s = __builtin_amdgcn_sinf(fr);
            if (isA) { cosA[j] = c; sinA[j] = s; } else { cosC[j] = c; sinC[j] = s; }
        }
    }
    {
        bf16* XB = (bf16*)(ws + WS_XB); unsigned long long* ss0 = ssbuf(ws, 0);
        for (int m = gw; m < M; m += NGW) {
            const GAS f32x4* xr = (const GAS f32x4*)(inp(0) + (size_t)m * DM) + lane; GAS unsigned long long* o8 = (GAS unsigned long long*)(XB + (size_t)m * DM) + lane; float s = 0.f;
#pragma unroll 4
            for (int j = 0; j < 16; ++j) { const f32x4 v = xr[64 * j]; s += (v.x * v.x + v.y * v.y) + (v.z * v.z + v.w * v.w);
                o8[64 * j] = (unsigned long long)pk2(v.x, v.y) | ((unsigned long long)pk2(v.z, v.w) << 32); }
            s = wave_sum(s);
            if (lane == 0) ss0[m] = (unsigned long long)(s * pg8::SS_SCALE + 0.5f);
        }
    }
}

namespace att {
typedef float f32x16 __attribute__((ext_vector_type(16)));
typedef short bf16x8 __attribute__((ext_vector_type(8)));
typedef short v4i16_t __attribute__((ext_vector_type(4)));
constexpr int RS = 272  , RSV = 320  , TILE = 64 * RS, BUF = TILE + 64 * RSV  , OFF_X = 0  , OFF_FLAG = 2 * BUF;
static_assert(2 * BUF >= 65536 && OFF_FLAG + 64 <= RING_BYTES, "attention LDS map");
constexpr float NEG_DONE = -160.0f;
struct TileRegs { v4u k[2], v[2]; };
__device__ __forceinline__ void tile_load(TileRegs& r, const bf16* Kg, int ldk, const bf16* Vg, int ldv, int tid_) {
    const int tid = pg8::launder_v(tid_);
#pragma unroll
    for (int i = 0; i < 2; ++i) { const int c = tid + 512 * i, row = c >> 4, ch = c & 15;
        r.k[i] = *(const GAS v4u*)(Kg + (unsigned)(row * ldk + ch * 8)); r.v[i] = *(const GAS v4u*)(Vg + (unsigned)(row * ldv + ch * 8)); }
}
__device__ __forceinline__ void tile_store(LAS unsigned char* buf, const TileRegs& r, int tid) {
#pragma unroll
    for (int i = 0; i < 2; ++i) { const int c = tid + 512 * i, row = c >> 4, ch = c & 15;
        *(LAS v4u*)(buf + row * RS + ch * 16) = r.k[i]; *(LAS v4u*)(buf + TILE + row * RSV + ch * 16) = r.v[i]; }
}
template <int NK> __device__ __forceinline__ void qk(f32x16 (&s)[2], const LAS unsigned char* kt, const bf16x8 (&qf)[NK], int lane) {
    const int r = lane & 31, h = lane >> 5;
#pragma unroll
    for (int kvt = 0; kvt < 2; ++kvt) {
        f32x16 a = {0.f, 0.f, 0.f, 0.f, 0.f, 0.f, 0.f, 0.f, 0.f, 0.f, 0.f, 0.f, 0.f, 0.f, 0.f, 0.f};
#pragma unroll
        for (int ks = 0; ks < NK; ++ks) { const bf16x8 kf = *(const LAS bf16x8*)(kt + (32 * kvt + r) * RS + (16 * ks + 8 * h) * 2); a = __builtin_amdgcn_mfma_f32_32x32x16_bf16(kf, qf[ks], a, 0, 0, 0); }
        s[kvt] = a; }
}
__device__ __forceinline__ void pv(f32x16 (&o)[4], const f32x16 (&p)[2], const LAS unsigned char* vt, int lane) {
    const int h = lane >> 5, g = (lane >> 4) & 1, i = lane & 15;
    const LAS unsigned char* vb = vt + (4 * h + (i >> 2)) * RSV + (16 * g + 4 * (i & 3)) * 2;
#pragma unroll
    for (int kvt = 0; kvt < 2; ++kvt)
#pragma unroll
        for (int s = 0; s < 2; ++s) {
            pg8::u32x4 pw; pw.x = pg8::cvt_pk_bf16(p[kvt][8 * s + 0], p[kvt][8 * s + 1]); pw.y = pg8::cvt_pk_bf16(p[kvt][8 * s + 2], p[kvt][8 * s + 3]);
            pw.z = pg8::cvt_pk_bf16(p[kvt][8 * s + 4], p[kvt][8 * s + 5]); pw.w = pg8::cvt_pk_bf16(p[kvt][8 * s + 6], p[kvt][8 * s + 7]);
            const bf16x8 pb = __builtin_bit_cast(bf16x8, pw);
#pragma unroll
            for (int dt = 0; dt < 4; ++dt) { const LAS unsigned char* a = vb + (32 * kvt + 16 * s) * RSV + 64 * dt;
                const v4i16_t lo = __builtin_amdgcn_ds_read_tr16_b64_v4i16((LAS v4i16_t*)a), hi = __builtin_amdgcn_ds_read_tr16_b64_v4i16((LAS v4i16_t*)(a + 8 * RSV));
                const bf16x8 va = {lo.x, lo.y, lo.z, lo.w, hi.x, hi.y, hi.z, hi.w};
                o[dt] = __builtin_amdgcn_mfma_f32_32x32x16_bf16(va, pb, o[dt], 0, 0, 0); } }
}
__device__ __forceinline__ void store_ot(bf16* dst, const f32x16 (&o)[4], float scale, int hi) {
#pragma unroll
    for (int dt = 0; dt < 4; ++dt)
#pragma unroll
        for (int p = 0; p < 2; ++p) { const int r0 = 8 * p, r1 = 8 * p + 4;
            unsigned ax = pg8::cvt_pk_bf16(o[dt][r0] * scale, o[dt][r0 + 1] * scale), ay = pg8::cvt_pk_bf16(o[dt][r0 + 2] * scale, o[dt][r0 + 3] * scale);
            unsigned bx = pg8::cvt_pk_bf16(o[dt][r1] * scale, o[dt][r1 + 1] * scale), by = pg8::cvt_pk_bf16(o[dt][r1 + 2] * scale, o[dt][r1 + 3] * scale);
            { const auto r = __builtin_amdgcn_permlane32_swap(ax, bx, false, false); ax = r[0]; bx = r[1]; }
            { const auto r = __builtin_amdgcn_permlane32_swap(ay, by, false, false); ay = r[0]; by = r[1]; }
            v4u w; w.x = ax; w.y = ay; w.z = bx; w.w = by;
            *(GAS v4u*)(dst + 32 * dt + 16 * p + 8 * hi) = w; }
}
template <int NK> __device__ __forceinline__ void load_q(bf16x8 (&qf)[NK], const bf16* qrow_ptr, int hi) {
#pragma unroll
    for (int ks = 0; ks < NK; ++ks) qf[ks] = *(const GAS bf16x8*)(qrow_ptr + 16 * ks + 8 * hi);
}
#define ATT_BAR() do { asm volatile("s_waitcnt lgkmcnt(0)" ::: "memory"); __builtin_amdgcn_s_barrier(); asm volatile("" ::: "memory"); } while (0)
__device__ __forceinline__ void softmax_tile(f32x16 (&s)[2], float& m, float& lsum, f32x16 (&o)[4], bool ozero) {
    float mx = -INFINITY;
#pragma unroll
    for (int kvt = 0; kvt < 2; ++kvt)
#pragma unroll
        for (int r = 0; r < 16; ++r) mx = fmaxf(mx, s[kvt][r]);
    mx = pg8::max32(mx);
    const float mn = fmaxf(m, mx);
    if (__any(mn > m)) { const float alpha = __builtin_amdgcn_exp2f(m - mn); m = mn; lsum *= alpha;
        if (!ozero) {
#pragma unroll
            for (int dt = 0; dt < 4; ++dt) o[dt] = o[dt] * alpha; } }
    float ps = 0.f;
#pragma unroll
    for (int kvt = 0; kvt < 2; ++kvt)
#pragma unroll
        for (int r = 0; r < 16; ++r) { const float e = __builtin_amdgcn_exp2f(s[kvt][r] - m); s[kvt][r] = e; ps += e; }
    lsum += ps;
}
__device__ __forceinline__ void pv_pk(f32x16 (&o)[4], const unsigned (&pw)[16], const LAS unsigned char* vt, int lane) {
    const int h = lane >> 5, g = (lane >> 4) & 1, i = lane & 15;
    const LAS unsigned char* vb = vt + (4 * h + (i >> 2)) * RSV + (16 * g + 4 * (i & 3)) * 2;
#pragma unroll
    for (int ks = 0; ks < 4; ++ks) {
        pg8::u32x4 w; w.x = pw[4 * ks]; w.y = pw[4 * ks + 1]; w.z = pw[4 * ks + 2]; w.w = pw[4 * ks + 3];
        const bf16x8 pb = __builtin_bit_cast(bf16x8, w);
#pragma unroll
        for (int dt = 0; dt < 4; ++dt) { const LAS unsigned char* a = vb + (16 * ks) * RSV + 64 * dt;
            const v4i16_t lo = __builtin_amdgcn_ds_read_tr16_b64_v4i16((LAS v4i16_t*)a), hi = __builtin_amdgcn_ds_read_tr16_b64_v4i16((LAS v4i16_t*)(a + 8 * RSV));
            const bf16x8 va = {lo.x, lo.y, lo.z, lo.w, hi.x, hi.y, hi.z, hi.w};
            o[dt] = __builtin_amdgcn_mfma_f32_32x32x16_bf16(va, pb, o[dt], 0, 0, 0); } }
}
template <bool MASK> __device__ __forceinline__ void softmax_pk(const f32x16 (&s_)[2], unsigned (&pw)[16], float& m, float& lsum, float& alpha, int kv0, int q, int hi) {
    f32x16 s[2] = {s_[0], s_[1]};
    if (MASK) {
#pragma unroll
        for (int kvt = 0; kvt < 2; ++kvt)
#pragma unroll
            for (int r = 0; r < 16; ++r) { const int kv = kv0 + 32 * kvt + (r & 3) + 8 * (r >> 2) + 4 * hi; if (kv > q) s[kvt][r] = -INFINITY; }
    }
    float mx0 = fmaxf(fmaxf(s[0][0], s[0][1]), s[0][2]), mx1 = fmaxf(fmaxf(s[1][0], s[1][1]), s[1][2]);
#pragma unroll
    for (int r = 3; r < 15; r += 2) { mx0 = fmaxf(fmaxf(mx0, s[0][r]), s[0][r + 1]); mx1 = fmaxf(fmaxf(mx1, s[1][r]), s[1][r + 1]); }
    float mx = fmaxf(fmaxf(mx0, mx1), fmaxf(s[0][15], s[1][15]));
    mx = pg8::max32(mx);
    const float mn = mx > m + 8.0f ? mx : m;
    alpha = __builtin_amdgcn_exp2f(m - mn); m = mn;
    float ps0 = 0.f, ps1 = 0.f;
#pragma unroll
    for (int kvt = 0; kvt < 2; ++kvt)
#pragma unroll
        for (int r2 = 0; r2 < 8; ++r2) { const float e0 = __builtin_amdgcn_exp2f(s[kvt][2 * r2] - mn), e1 = __builtin_amdgcn_exp2f(s[kvt][2 * r2 + 1] - mn); ps0 += e0; ps1 += e1;
            pw[8 * kvt + r2] = pg8::cvt_pk_bf16(e0, e1); }
    lsum = lsum * alpha + (ps0 + ps1);
    asm volatile("" : "+v"(pw[0]), "+v"(pw[1]), "+v"(pw[2]), "+v"(pw[3]), "+v"(pw[4]), "+v"(pw[5]), "+v"(pw[6]), "+v"(pw[7]));
    asm volatile("" : "+v"(pw[8]), "+v"(pw[9]), "+v"(pw[10]), "+v"(pw[11]), "+v"(pw[12]), "+v"(pw[13]), "+v"(pw[14]), "+v"(pw[15]));
    asm volatile("" : "+v"(lsum), "+v"(m), "+v"(alpha));
}
#define SGB(mask, n) __builtin_amdgcn_sched_group_barrier(mask, n, 0)
__device__ __forceinline__ void c_step_pipeline() {
    SGB(0x100, 8);
#pragma unroll
    for (int i = 0; i < 24; ++i) { SGB(0x008, 1); if (i < 12) SGB(0x100, 2); else if (i < 20) SGB(0x100, 1); SGB(0x402, 6); }
}
}

__device__ __forceinline__ void attn_a(Frame& F, int l) {
    using namespace att;
    unsigned char* const ws = launder_p(F.ws);
    const bf16* QA = (const bf16*)(ws + WS_QKV); const bf16* KA = QA + (size_t)M * 2048; const bf16* VA = KA + (size_t)M * 512; bf16* OA = (bf16*)(ws + WS_OA);
    LAS unsigned char* lds = F.lds + RING_OFF;
    const int lane = pg8::lane_id(), wave = F.wave, tid = wave * 64 + lane, r32 = lane & 31, hi = lane >> 5;
    for (int u = F.vcu; u < 1024; u += F.G) {
        const int qb = u & 63, kvh = (u >> 6) & 3, b = u >> 8, hq = 4 * kvh + (wave >> 1), qw = qb * 64 + 32 * (wave & 1), q = qw + r32; const size_t qrow = (size_t)b * SEQ + q;
        bf16x8 qf[8]; load_q<8>(qf, QA + qrow * 2048 + hq * 128, hi);
        float m = inp(7)[l * 16 + hq] * 1.44269504089f, lsum = hi ? 0.f : 1.f;
        f32x16 o[4];
#pragma unroll
        for (int dt = 0; dt < 4; ++dt)
#pragma unroll
            for (int r = 0; r < 16; ++r) o[dt][r] = 0.f;
        const int t_lo = qb - 2 < 0 ? 0 : qb - 2, t_hi = qb;
        const bf16* Kb = KA + (size_t)b * SEQ * 512 + kvh * 128; const bf16* Vb = VA + (size_t)b * SEQ * 512 + kvh * 128;
        TileRegs tr; tile_load(tr, Kb + (size_t)t_lo * 64 * 512, 512, Vb + (size_t)t_lo * 64 * 512, 512, tid);
        tile_store(lds, tr, tid); ATT_BAR();
        if (t_lo < t_hi) tile_load(tr, Kb + (size_t)(t_lo + 1) * 64 * 512, 512, Vb + (size_t)(t_lo + 1) * 64 * 512, 512, tid);
        for (int t = t_lo; t <= t_hi; ++t) {
            LAS unsigned char* cur = lds + ((t - t_lo) & 1) * BUF; LAS unsigned char* nxt = lds + ((t - t_lo + 1) & 1) * BUF;
            if (t < t_hi) tile_store(nxt, tr, tid);
            if (t + 1 < t_hi) tile_load(tr, Kb + (size_t)(t + 2) * 64 * 512, 512, Vb + (size_t)(t + 2) * 64 * 512, 512, tid);
            const int kv0 = 64 * t;
            if (kv0 <= qw + 31 && kv0 + 63 > qw - 128) {
                f32x16 s[2]; qk<8>(s, cur, qf, lane);
                if (t == t_hi) {
#pragma unroll
                    for (int kvt = 0; kvt < 2; ++kvt)
#pragma unroll
                        for (int r = 0; r < 16; ++r) { const int kv = kv0 + 32 * kvt + (r & 3) + 8 * (r >> 2) + 4 * hi; if (kv > q) s[kvt][r] = -INFINITY; }
                } else if (t + 2 == t_hi) {
#pragma unroll
                    for (int kvt = 0; kvt < 2; ++kvt)
#pragma unroll
                        for (int r = 0; r < 16; ++r) { const int kv = kv0 + 32 * kvt + (r & 3) + 8 * (r >> 2) + 4 * hi; if (q - kv >= 128) s[kvt][r] = -INFINITY; }
                }
                softmax_tile(s, m, lsum, o, t == t_lo);
                pv(o, s, cur + TILE, lane);
            }
            ATT_BAR();
        }
        const float lt = pg8::sum32(lsum);
        store_ot(OA + qrow * 2048 + hq * 128, o, 1.0f / lt, hi);
    }
}
__device__ __forceinline__ void attn_b(Frame& F, int l) {
    using namespace att;
    unsigned char* const ws = launder_p(F.ws);
    const bf16* QB = (const bf16*)(ws + WS_QKV) + (size_t)M * 3072; const bf16* KB = QB + (size_t)M * 1024; const bf16* VB = KB + (size_t)M * 1024; bf16* OB = (bf16*)(ws + WS_OA) + (size_t)M * 2048;
    LAS unsigned char* lds = F.lds + RING_OFF; volatile LAS float* flags = (volatile LAS float*)(lds + OFF_FLAG);
    const int lane = pg8::lane_id(), wave = F.wave, tid = wave * 64 + lane, r32 = lane & 31, hi = lane >> 5;
    for (int u = F.vcu; u < 512; u += F.G) {
        const int qb = u & 15, h = (u >> 4) & 7, b = u >> 7, q0 = qb * 256, qw = q0 + 32 * wave, q = qw + r32; const size_t qrow = (size_t)b * SEQ + q;
        bf16x8 qf[8]; load_q<8>(qf, QB + qrow * 1024 + h * 128, hi);
        float run = 0.f;
        f32x16 o[4];
#pragma unroll
        for (int dt = 0; dt < 4; ++dt)
#pragma unroll
            for (int r = 0; r < 16; ++r) o[dt][r] = 0.f;
        const int t_hi = qb * 4 + 3;
        const bf16* Kb = KB + (size_t)b * SEQ * 1024 + h * 128; const bf16* Vb = VB + (size_t)b * SEQ * 1024 + h * 128;
        TileRegs tr; tile_load(tr, Kb + (size_t)t_hi * 64 * 1024, 1024, Vb + (size_t)t_hi * 64 * 1024, 1024, tid);
        tile_store(lds, tr, tid); ATT_BAR();
        tile_load(tr, Kb + (size_t)(t_hi - 1) * 64 * 1024, 1024, Vb + (size_t)(t_hi - 1) * 64 * 1024, 1024, tid);
        for (int t = t_hi; t >= 0; --t) {
            const int par = (t_hi - t) & 1;
            LAS unsigned char* cur = lds + par * BUF; LAS unsigned char* nxt = lds + (par ^ 1) * BUF;
            if (t > 0) tile_store(nxt, tr, tid);
            if (t > 1) tile_load(tr, Kb + (size_t)(t - 2) * 64 * 1024, 1024, Vb + (size_t)(t - 2) * 64 * 1024, 1024, tid);
            const int kv0 = 64 * t;
            float wmax = wave_max(run);
            if (kv0 < qw + 31 && wmax >= NEG_DONE) {
                f32x16 s[2]; qk<8>(s, cur, qf, lane);
                f32x16 l1[2];
#pragma unroll
                for (int kvt = 0; kvt < 2; ++kvt)
#pragma unroll
                    for (int r = 0; r < 16; ++r) { const float z = s[kvt][r];
                        const float lb = fminf(z, 0.f) - __builtin_amdgcn_logf(1.0f + __builtin_amdgcn_exp2f(-fabsf(z)));
                        s[kvt][r] = lb; l1[kvt][r] = lb - z; }
                if (kv0 + 63 >= qw) {
#pragma unroll
                    for (int kvt = 0; kvt < 2; ++kvt)
#pragma unroll
                        for (int r = 0; r < 16; ++r) { const int kv = kv0 + 32 * kvt + (r & 3) + 8 * (r >> 2) + 4 * hi; const bool valid = kv < q;
                            s[kvt][r] = valid ? s[kvt][r] : -INFINITY; l1[kvt][r] = valid ? l1[kvt][r] : 0.f; } }
                float gs[8], og[8];
#pragma unroll
                for (int gi = 0; gi < 8; ++gi) { const int kvt = gi >> 2, rq = gi & 3; gs[gi] = (l1[kvt][4 * rq] + l1[kvt][4 * rq + 1]) + (l1[kvt][4 * rq + 2] + l1[kvt][4 * rq + 3]); og[gi] = pg8::xor32(gs[gi], hi); }
                float above = run;
#pragma unroll
                for (int gi = 7; gi >= 0; --gi) { const int kvt = gi >> 2, rq = gi & 3;
                    const float sg = above + (hi ? 0.f : og[gi]);
                    const float a3 = sg, a2 = a3 + l1[kvt][4 * rq + 3], a1 = a2 + l1[kvt][4 * rq + 2], a0 = a1 + l1[kvt][4 * rq + 1];
                    s[kvt][4 * rq + 3] = __builtin_amdgcn_exp2f(s[kvt][4 * rq + 3] + a3); s[kvt][4 * rq + 2] = __builtin_amdgcn_exp2f(s[kvt][4 * rq + 2] + a2);
                    s[kvt][4 * rq + 1] = __builtin_amdgcn_exp2f(s[kvt][4 * rq + 1] + a1); s[kvt][4 * rq + 0] = __builtin_amdgcn_exp2f(s[kvt][4 * rq + 0] + a0);
                    above += gs[gi] + og[gi]; }
                run = above;
                pv(o, s, cur + TILE, lane);
                wmax = wave_max(run);
            }
            if (lane == 0) flags[par * 8 + wave] = wmax;
            ATT_BAR();
            float gmax = flags[par * 8];
#pragma unroll
            for (int w = 1; w < 8; ++w) gmax = fmaxf(gmax, flags[par * 8 + w]);
            if (gmax < NEG_DONE) break;
        }
        store_ot(OB + qrow * 2048 + h * 128, o, 1.0f, hi);
        ATT_BAR();
    }
}
#define C_SLOT(j) do { const int kj_ = (j) < nt ? (j) : nt - 1, vj_ = (j) < 2 ? 0 : ((j) - 2 < nt ? (j) - 2 : nt - 1); tile_load(tr, Kb + (size_t)kj_ * 64 * 1024, 1024, Vb + (size_t)vj_ * 64 * 1024, 1024, tid); } while (0)
#define C_RESCALE() do { if (__any(alpha != 1.0f)) { _Pragma("unroll") for (int dt = 0; dt < 4; ++dt) o[dt] = o[dt] * alpha; } } while (0)
#define C_STEP(SC, SN, MASK, T) do { const int t_ = (T); LAS unsigned char* cur = lds + ((t_ + 1) & 1) * BUF; LAS unsigned char* nxt = lds + (t_ & 1) * BUF; \
        tile_store(nxt, tr, tid); C_SLOT(t_ + 3); C_RESCALE(); \
        pv_pk(o, pw, cur + TILE, lane); qk<4>(SN, cur + 128 * c, qf, lane); softmax_pk<MASK>(SC, pw, m, lsum, alpha, 64 * t_, q, hi); c_step_pipeline(); \
        ATT_BAR(); } while (0)
__device__ __forceinline__ void attn_c(Frame& F, int l) {
    using namespace att;
    unsigned char* const ws = launder_p(F.ws);
    const bf16* QC = (const bf16*)(ws + WS_QKV) + (size_t)M * 6144; const bf16* KC = QC + (size_t)M * 1024; const bf16* VC = KC + (size_t)M * 1024; bf16* OC = (bf16*)(ws + WS_OA) + (size_t)M * 2048 + 1024;
    LAS unsigned char* lds = F.lds + RING_OFF; LAS float* xch = (LAS float*)(lds + OFF_X);
    const int lane = pg8::lane_id(), wave = F.wave, tid = wave * 64 + lane, r32 = lane & 31, hi = lane >> 5, wq = wave & 3, c = wave >> 2;
    const float lam_init = 0.8f - 0.6f * expf(-0.3f * (float)l);
    const float lam = expf(wave_sum(inp(8)[l * 64 + lane] * inp(9)[l * 64 + lane])) - expf(wave_sum(inp(10)[l * 64 + lane] * inp(11)[l * 64 + lane])) + lam_init;
    const float* gptr = inp(12) + l * 128;
#define C_FETCH(p_, half_) do { const int b_ = (p_) >> 7, h_ = ((p_) >> 4) & 7, qb_ = (half_) ? 31 - ((p_) & 15) : ((p_) & 15); \
        const bf16* Kn_ = KC + (size_t)b_ * SEQ * 1024 + h_ * 128; const bf16* Vn_ = VC + (size_t)b_ * SEQ * 1024 + h_ * 128; \
        tile_load(tr, Kn_, 1024, Vn_, 1024, tid); tile_load(tr1, Kn_ + (size_t)64 * 1024, 1024, Vn_, 1024, tid); \
        load_q<4>(qf, QC + ((size_t)b_ * SEQ + qb_ * 128 + 32 * wq + r32) * 1024 + h_ * 128 + 64 * c, hi); } while (0)
    TileRegs tr, tr1; bf16x8 qf[4];
    if (F.vcu < 512) C_FETCH(F.vcu, 0);
    for (int p = F.vcu; p < 512; p += F.G) {
        const int bh = p >> 4, x = p & 15, b = bh >> 3, h = bh & 7;
        const bf16* Kb = KC + (size_t)b * SEQ * 1024 + h * 128; const bf16* Vb = VC + (size_t)b * SEQ * 1024 + h * 128;
        for (int half = 0; half < 2; ++half) {
            const int qblk = half ? 31 - x : x, q0 = qblk * 128, qw = q0 + 32 * wq, q = qw + r32; const size_t qrow = (size_t)b * SEQ + q;
            float m = -INFINITY, lsum = 0.f, alpha = 1.0f;
            f32x16 o[4];
#pragma unroll
            for (int dt = 0; dt < 4; ++dt)
#pragma unroll
                for (int r = 0; r < 16; ++r) o[dt][r] = 0.f;
            unsigned pw[16];
#pragma unroll
            for (int i = 0; i < 16; ++i) pw[i] = 0u;
            const int nt = 2 * qblk + 2;
            f32x16 sA[2], sB[2];
            tile_store(lds, tr, tid); tile_store(lds + BUF, tr1, tid); C_SLOT(2); ATT_BAR();
            qk<4>(sA, lds + 128 * c, qf, lane); ATT_BAR();
            for (int t = 0; t + 2 < nt; t += 2) { C_STEP(sA, sB, false, t); C_STEP(sB, sA, false, t + 1); }
            C_STEP(sA, sB, true, nt - 2); C_STEP(sB, sA, true, nt - 1);
            C_RESCALE(); pv_pk(o, pw, lds + ((nt + 1) & 1) * BUF + TILE, lane);
            ATT_BAR();
            const float lt = pg8::sum32(lsum);
            if (c == 1) { const float sc = lam / lt;
#pragma unroll
                for (int dt = 0; dt < 4; ++dt)
#pragma unroll
                    for (int r = 0; r < 16; ++r) xch[(wq * 64 + dt * 16 + r) * 64 + lane] = o[dt][r] * sc; }
            ATT_BAR();
            float ss = 0.f;
            if (c == 0) { const float sc = 1.0f / lt;
#pragma unroll
                for (int dt = 0; dt < 4; ++dt)
#pragma unroll
                    for (int r = 0; r < 16; ++r) { const float y = o[dt][r] * sc - xch[(wq * 64 + dt * 16 + r) * 64 + lane]; o[dt][r] = y; ss += y * y; } }
            asm volatile("" ::: "memory");
            { const int pn = half ? p + F.G : p, hn = half ^ 1; if (pn < 512) C_FETCH(pn, hn); }
            if (c == 0) {
                ss = pg8::sum32(ss);
                const float rn = rsqrtf(ss * (1.0f / 128.0f) + 1e-5f) * (1.0f - lam_init);
#pragma unroll
                for (int dt = 0; dt < 4; ++dt)
#pragma unroll
                    for (int rq = 0; rq < 4; ++rq) { const f32x4 g = *(const GAS f32x4*)(gptr + 32 * dt + 8 * rq + 4 * hi);
                        o[dt][4 * rq] *= g.x * rn; o[dt][4 * rq + 1] *= g.y * rn; o[dt][4 * rq + 2] *= g.z * rn; o[dt][4 * rq + 3] *= g.w * rn; }
                store_ot(OC + qrow * 2048 + h * 128, o, 1.0f, hi); }
            ATT_BAR();
        }
    }
}

__device__ __forceinline__ void final_norm(Frame& F) {
    unsigned char* const ws = launder_p(F.ws);
    const bf16* XB = (const bf16*)(ws + WS_XB); const float* g = inp(20); const int lane = pg8::lane_id();
    const int gw = F.vcu * NWAVES + F.wave, NGW = F.G * NWAVES;
    for (int m = gw; m < M; m += NGW) {
        const GAS v4u* xr = (const GAS v4u*)(XB + (size_t)m * DM) + lane; GAS f32x4* orow = (GAS f32x4*)(F.out + (size_t)m * DM) + 2 * lane; const GAS f32x4* gr = (const GAS f32x4*)g + 2 * lane;
        f32x4 v[16]; float s = 0.f;
#pragma unroll
        for (int j = 0; j < 8; ++j) { pg8::unpack8(xr[64 * j], v[2 * j], v[2 * j + 1]);
            s += (v[2 * j].x * v[2 * j].x + v[2 * j].y * v[2 * j].y) + (v[2 * j].z * v[2 * j].z + v[2 * j].w * v[2 * j].w) + (v[2 * j + 1].x * v[2 * j + 1].x + v[2 * j + 1].y * v[2 * j + 1].y) + (v[2 * j + 1].z * v[2 * j + 1].z + v[2 * j + 1].w * v[2 * j + 1].w); }
        const float rs = rsqrtf(wave_sum(s) * (1.0f / DM) + 1e-6f);
#pragma unroll
        for (int j = 0; j < 8; ++j) { orow[128 * j] = v[2 * j] * rs * gr[128 * j]; orow[128 * j + 1] = v[2 * j + 1] * rs * gr[128 * j + 1]; }
    }
}

#define GP(Epi) pg8::gemm_phase<Epi, pg8::StaticOrder, true, true>
__device__ __forceinline__ void ph_ffn_in(Frame& F, int l, int which) {
    unsigned char* const ws = launder_p(F.ws);
    pg8::StaticOrder S; S.init(M, 2 * DFF, launder_i(F.G), launder_i(F.cid));
    if (which && FFN2_FP8(l)) {
        pg8::Gemm g{(const bf16*)(ws + WS_XB8), (const bf16*)(ws + WS_W3F8), M, 2 * DFF, DM / 2};
        pg8::EpiSwigluT<true> E{(bf16*)(ws + WS_HID), ssbuf(ws, 3 * l + 2), {}, 1.0f / 64.0f}; { pg8::Unit u0; u0.pm = 0; u0.pn = 0; E.R.pm = -1; if (S.next(0, u0)) E.R.load(E.ss, u0.pm, F.wave, pg8::lane_id(), 1.0f / 64.0f); }
        pg8::gemm_phase<pg8::EpiSwigluT<true>, pg8::StaticOrder, true, true, true>(F.lds + RING_OFF, g, S, E, F.wave);
        return;
    }
    pg8::Gemm g{(const bf16*)(ws + WS_XB), wgt(ws, l, which ? WO_W3 : WO_W1), M, 2 * DFF, DM};
    pg8::EpiSwiglu E{(bf16*)(ws + WS_HID), ssbuf(ws, 3 * l + (which ? 2 : 0)), {}, 1.0f}; { pg8::Unit u0; u0.pm = 0; u0.pn = 0; E.R.pm = -1; if (S.next(0, u0)) E.R.load(E.ss, u0.pm, F.wave, pg8::lane_id(), 1.0f); }
    GP(pg8::EpiSwiglu)(F.lds + RING_OFF, g, S, E, F.wave);
}
__device__ __forceinline__ void ph_ffn_out(Frame& F, int l, int which) {
    unsigned char* const ws = launder_p(F.ws);
    pg8::Gemm g{(const bf16*)(ws + WS_HID), wgt(ws, l, which ? WO_W4 : WO_W2), M, DM, DFF}; pg8::StaticOrder S; S.init(M, DM, launder_i(F.G), launder_i(F.cid));
    if (which == 0) {
        pg8::EpiResid<true> E{l == 0 ? inp(0) : nullptr, (bf16*)(ws + WS_XB), ssbuf(ws, 3 * l + 1), 0.5f, (long)WS_XB8 - (long)WS_XB};
        GP(pg8::EpiResid<true>)(F.lds + RING_OFF, g, S, E, F.wave);
    } else if (FFN2_FP8(l)) {
        pg8::Gemm g8{(const bf16*)(ws + WS_HID), (const bf16*)(ws + WS_W4F8), M, DM, DFF / 2};
        pg8::EpiResid<false> E{nullptr, (bf16*)(ws + WS_XB), ssbuf(ws, 3 * (l + 1)), 0.5f / 64.0f, 0};
        pg8::gemm_phase<pg8::EpiResid<false>, pg8::StaticOrder, true, true, true>(F.lds + RING_OFF, g8, S, E, F.wave);
    } else {
        pg8::EpiResid<false> E{nullptr, (bf16*)(ws + WS_XB), ssbuf(ws, 3 * (l + 1)), 0.5f, 0};
        GP(pg8::EpiResid<false>)(F.lds + RING_OFF, g, S, E, F.wave);
    }
}
__device__ __forceinline__ void ph_qkvg(Frame& F, int l) {
    unsigned char* const ws = launder_p(F.ws);
    pg8::Gemm g{(const bf16*)(ws + WS_XB), wgt(ws, l, WO_QG), M, NQKV, DM}; pg8::StaticOrder S; S.init(M, NQKV, launder_i(F.G), launder_i(F.cid));
    const float* cosA = (const float*)(ws + WS_ROPE);
    pg8::EpiQKVG E{(bf16*)(ws + WS_QKV), (bf16*)(ws + WS_GATES), ssbuf(ws, 3 * l + 1), cosA, cosA + 4096 * 64, cosA + 2 * 4096 * 64, cosA + 2 * 4096 * 64 + 4096 * 32, {}}; { pg8::Unit u0; u0.pm = 0; u0.pn = 0; E.R.pm = -1; if (S.next(0, u0)) E.R.load(E.ss, u0.pm, F.wave, pg8::lane_id(), 1.0f); }
    GP(pg8::EpiQKVG)(F.lds + RING_OFF, g, S, E, F.wave);
}
__device__ __forceinline__ void ph_gates(Frame& F, int l) {
    unsigned char* const ws = launder_p(F.ws);
    pg8::Gemm g{(const bf16*)(ws + WS_XB8), (const bf16*)(ws + WS_WG8 + (size_t)l * WG8_LAYER), M, NGATE, DM / 2}; pg8::StaticOrder S; S.init(M, NGATE, launder_i(F.G), launder_i(F.cid));
    pg8::EpiGates E{ws + WS_GATES, ssbuf(ws, 3 * l + 1), {}}; { pg8::Unit u0; u0.pm = 0; u0.pn = 0; E.R.pm = -1; if (S.next(0, u0)) E.R.load(E.ss, u0.pm, F.wave, pg8::lane_id(), 1.0f / 64.0f); }
    pg8::gemm_phase<pg8::EpiGates, pg8::StaticOrder, true, true, true>(F.lds + RING_OFF, g, S, E, F.wave);
}
__device__ __forceinline__ void ph_branches(Frame& F, int l) {
    unsigned char* const ws = launder_p(F.ws);
    const bf16* OA = (const bf16*)(ws + WS_OA);
    pg8::MergeGemm g{OA, OA + (size_t)M * 2048, wgt(ws, l, WO_A), wgt(ws, l, WO_B), ws + WS_GATES, (bf16*)(ws + WS_MB)};
    pg8::StaticOrder S; S.init(M, DM, launder_i(F.G), launder_i(F.cid));
    pg8::gemm_phase_merge(F.lds + RING_OFF, g, S, F.wave);
}
__device__ __forceinline__ void ph_wout(Frame& F, int l) {
    unsigned char* const ws = launder_p(F.ws);
    pg8::Gemm g{(const bf16*)(ws + WS_MB), wgt(ws, l, WO_O), M, DM, DM}; pg8::StaticOrder S; S.init(M, DM, launder_i(F.G), launder_i(F.cid));
    if (FFN2_FP8(l)) { pg8::EpiResid<true> E{nullptr, (bf16*)(ws + WS_XB), ssbuf(ws, 3 * l + 2), 1.0f, (long)WS_XB8 - (long)WS_XB}; GP(pg8::EpiResid<true>)(F.lds + RING_OFF, g, S, E, F.wave); return; }
    pg8::EpiResid<false> E{nullptr, (bf16*)(ws + WS_XB), ssbuf(ws, 3 * l + 2), 1.0f, 0};
    GP(pg8::EpiResid<false>)(F.lds + RING_OFF, g, S, E, F.wave);
}

__global__ void __launch_bounds__(NWAVES * 64, 2) mk_fwd(Args args) {
    extern __shared__ __attribute__((aligned(16))) unsigned char lds[];
    Frame F;
    F.lds = (LAS unsigned char*)lds;
    F.MISC = (volatile LAS unsigned*)(F.lds + MISC_OFF);
    F.wave = __builtin_amdgcn_readfirstlane((int)threadIdx.x >> 6); asm volatile("" : "+s"(F.wave));
    F.G = gridDim.x; { const int bx = blockIdx.x; F.vcu = (F.G % 8 == 0) ? (bx % 8) * (F.G / 8) + bx / 8 : bx; }
    F.ws = args.ws; F.out = args.out;
    F.ctl = (gu32*)(args.ws + WS_CTL);
    for (int u = threadIdx.x; u < (LDS_BYTES - LDSCTL_OFF) / 4; u += NWAVES * 64) ((LAS unsigned*)(F.lds + LDSCTL_OFF))[u] = 0u;
    __syncthreads();
#if MK_PER_PHASE
    const int lo = args.ph_lo, hi = args.ph_hi;
#else
    constexpr int lo = 0, hi = NPH;
#endif
    XcdBarrier bar; bar.bar = (unsigned*)(F.ctl + CW_BAR) + args.li * XCD_BAR_WORDS; bar.x = 0; bar.st = nullptr;
    if (hi - lo > 1) bar = xcd_barrier_post((unsigned*)(F.ctl + CW_BAR) + args.li * XCD_BAR_WORDS, F.MISC + 8);
    F.cid = blockIdx.x;
    if (hi - lo > 1 && F.wave == 0 && pg8::lane_id() == 0) { const unsigned x = xb_xcc_id(); F.MISC[10] = x; F.MISC[11] = xb_add((unsigned*)(F.ctl + CW_TICKET) + 64 * x, 1u); }
#define IN(k) (lo <= (k) && (k) < hi)
#define SEAM(k) do { if (IN(k) && IN((k) + 1)) xcd_barrier(bar, F.wave); } while (0)

    if (IN(0)) { p0_prologue(F); convert_jobs(F, 0, J_W1, J_W2); SEAM(0); }
    if (hi - lo > 1) {
        if (F.wave == 0 && pg8::lane_id() == 0) { unsigned ok = (F.G % 8 == 0) ? 1u : 0u; unsigned* bw = (unsigned*)(F.ctl + CW_BAR) + args.li * XCD_BAR_WORDS;
            for (unsigned j = 0; j < 16; ++j) { const unsigned c = xb_ld(&bw[XB_XCNT(j)]); ok &= (c == (j < 8 ? (unsigned)F.G / 8u : 0u)) ? 1u : 0u; }
            F.MISC[12] = ok; }
        __syncthreads();
        if (F.MISC[12]) { const int x = (int)F.MISC[10], r = (int)F.MISC[11]; F.cid = __builtin_amdgcn_readfirstlane(r * 8 + x); F.vcu = __builtin_amdgcn_readfirstlane(x * (F.G / 8) + r); }
    }
    for (int l = 0; l < DEPTH; ++l) {
        const int pb = 1 + 8 * l; const bool cf = (F.cid & 1) != 0;
#define CONV(first, lyr, a, b) do { if ((first) == cf) { convert_jobs(F, lyr, a, b); if (first) __syncthreads(); } } while (0)
        if (IN(pb + 0)) { CONV(true, l, J_W2, J_QKV); ph_ffn_in(F, l, 0); CONV(false, l, J_W2, J_QKV); SEAM(pb + 0); }
        if (IN(pb + 1)) { CONV(true, l, J_QKV, J_A); ph_ffn_out(F, l, 0); CONV(false, l, J_QKV, J_A); SEAM(pb + 1); }
        if (IN(pb + 2)) { ph_qkvg(F, l); ph_gates(F, l); SEAM(pb + 2); }
        if (IN(pb + 3)) { CONV(true, l, J_A, J_O); attn_a(F, l); attn_b(F, l); attn_c(F, l); CONV(false, l, J_A, J_O); SEAM(pb + 3); }
        if (IN(pb + 4)) { CONV(true, l, J_O, J_W3); ph_branches(F, l); CONV(false, l, J_O, J_W3); SEAM(pb + 4); }
        if (IN(pb + 5)) { CONV(true, l, J_W3, J_W4); ph_wout(F, l); CONV(false, l, J_W3, J_W4); SEAM(pb + 5); }
        if (IN(pb + 6)) { CONV(true, l, J_W4, I_LAYER); ph_ffn_in(F, l, 1); CONV(false, l, J_W4, I_LAYER); SEAM(pb + 6); }
        if (IN(pb + 7)) { if (l + 1 < DEPTH) CONV(true, l + 1, J_W1, J_W2); ph_ffn_out(F, l, 1); if (l + 1 < DEPTH) CONV(false, l + 1, J_W1, J_W2); SEAM(pb + 7); }
#undef CONV
    }
    if (IN(NPH - 1)) final_norm(F);
#undef IN
#undef SEAM
}

extern "C" void kernel_launch(void* const* d_in, const int* in_sizes, int n_in, void* d_out, int out_size, void* d_ws, size_t ws_size, hipStream_t stream) {
    static int grid = 0;
    if (grid == 0) {
        if (n_in != 21 || in_sizes[0] != M * DM || out_size != M * DM || ws_size < WS_END) { fprintf(stderr, "kernel_launch: unexpected shapes (n_in %d, in0 %d, out %d, ws %zu < %zu); nothing launched\n", n_in, n_in > 0 ? in_sizes[0] : -1, out_size, ws_size, (size_t)WS_END); grid = -1; return; }
        int dev = 0, cus = 0, per_cu = 0;
        if (hipGetDevice(&dev) != hipSuccess || hipDeviceGetAttribute(&cus, hipDeviceAttributeMultiprocessorCount, dev) != hipSuccess) { grid = -1; return; }
        if (hipFuncSetAttribute((const void*)mk_fwd, hipFuncAttributeMaxDynamicSharedMemorySize, LDS_BYTES) != hipSuccess) { fprintf(stderr, "kernel_launch: hipFuncSetAttribute failed\n"); grid = -1; return; }
        if (hipOccupancyMaxActiveBlocksPerMultiprocessor(&per_cu, (const void*)mk_fwd, NWAVES * 64, LDS_BYTES) != hipSuccess || per_cu < 1) fprintf(stderr, "kernel_launch: occupancy query reports %d\n", per_cu);
        (void)hipGetLastError();
        grid = cus;
    }
    if (grid < 0) return;
    if (hipMemsetAsync((char*)d_ws + WS_CTL, 0, CTL_ZERO_BYTES, stream) != hipSuccess) { fprintf(stderr, "kernel_launch: hipMemsetAsync failed\n"); return; }
    Args a{};
    for (int i = 0; i < 21; ++i) a.in[i] = (const float*)d_in[i];
    a.out = (float*)d_out; a.ws = (unsigned char*)d_ws; a.pad = 0;
#if MK_PER_PHASE
    for (int p = 0; p < NPH; ++p) { a.ph_lo = p; a.ph_hi = p + 1; a.li = 0; hipLaunchKernelGGL(mk_fwd, dim3(grid), dim3(NWAVES * 64), LDS_BYTES, stream, a); }
#else
    a.ph_lo = 0; a.ph_hi = NPH; a.li = 0;
    hipLaunchKernelGGL(mk_fwd, dim3(grid), dim3(NWAVES * 64), LDS_BYTES, stream, a);
#endif
    const hipError_t le = hipPeekAtLastError();
    if (le != hipSuccess) fprintf(stderr, "kernel_launch: launch failed: %s\n", hipGetErrorName(le));
}
```

```cpp
#include <hip/hip_runtime.h>
#include <cstdio>
#include <cstdint>

#ifndef MK_PER_PHASE
#define MK_PER_PHASE 0
#endif

namespace pg8 {
#define PG8_LAS __attribute__((address_space(3)))
typedef unsigned short bf16_t;
typedef short bf16x8 __attribute__((ext_vector_type(8)));
typedef float f32x4 __attribute__((ext_vector_type(4)));
typedef unsigned u32x4 __attribute__((ext_vector_type(4)));
constexpr int BM = 256, BK = 64, HALF = 128, HTB = HALF * BK * 2  , STAGE_BYTES = 8 * HTB, NXCD = 8, WGM = 8;

__host__ __device__ __forceinline__ int lds_byte(int r, int c) { const int st = (r >> 4) * 2 + (c >> 5), rr = r & 15, cc = c & 31, ob = rr * 64 + cc * 2; return st * 1024 + (ob ^ (((ob >> 9) & 1) << 5)); }
__host__ __device__ __forceinline__ void stage_rc(int b, int& R, int& C) { const int st = b / 1024, sb = b % 1024, swz = sb ^ (((sb >> 9) & 1) << 5); R = (st >> 1) * 16 + swz / 64; C = (st & 1) * 32 + (swz % 64) / 2; }
__host__ __device__ __forceinline__ int perm32(int rho) { const int n = rho >> 4, i = rho & 15; return 8 * (i >> 2) + 4 * n + (i & 3); }

__device__ __forceinline__ int launder_v(int x) { asm volatile("" : "+v"(x)); return x; }
__device__ __forceinline__ int lane_id() { int x; asm volatile("v_mbcnt_lo_u32_b32 %0, -1, 0\n\tv_mbcnt_hi_u32_b32 %0, -1, %0" : "=v"(x)); return x; }
template <int O> __device__ __forceinline__ float xor_lt32(float v) { return __int_as_float(__builtin_amdgcn_ds_swizzle(__float_as_int(v), (O << 10) | 0x1f)); }
__device__ __forceinline__ float xor32(float v, int hi) { const auto rr = __builtin_amdgcn_permlane32_swap(__float_as_uint(v), __float_as_uint(v), false, false); return __uint_as_float(hi ? rr[0] : rr[1]); }
__device__ __forceinline__ float sum32(float v) { const auto rr = __builtin_amdgcn_permlane32_swap(__float_as_uint(v), __float_as_uint(v), false, false); return __uint_as_float(rr[0]) + __uint_as_float(rr[1]); }
__device__ __forceinline__ float max32(float v) { const auto rr = __builtin_amdgcn_permlane32_swap(__float_as_uint(v), __float_as_uint(v), false, false); return fmaxf(__uint_as_float(rr[0]), __uint_as_float(rr[1])); }
struct Unit { int pm, pn; };
struct Gemm { const bf16_t* A; const bf16_t* Bt; int M, N, K; };

struct StaticOrder {
    int nM, nN, nwg, G, c;
    __host__ __device__ void init(int M, int N, int G_, int c_) { nM = M / BM; nN = N / BM; nwg = nM * nN; G = G_; c = c_; }
    __host__ __device__ bool next(int i, Unit& u) const {
        const long L = (long)i * G + c; if (L >= nwg) return false;
        int wgid = (int)L; { const int q = nwg / NXCD, r = nwg % NXCD, xcd = wgid % NXCD, off = wgid / NXCD; wgid = (xcd < r ? xcd * (q + 1) : r * (q + 1) + (xcd - r) * q) + off; }
        const int nig = WGM * nN, gid = wgid / nig, fm = gid * WGM, gsz = (nM - fm) < WGM ? (nM - fm) : WGM;
        u.pm = fm + ((wgid % nig) % gsz); u.pn = (wgid % nig) / gsz;
        { const int rot = (c % NXCD) * (nN / NXCD); u.pn += rot; if (u.pn >= nN) u.pn -= nN; }
        return true;
    }
    __device__ __forceinline__ void a_ready(const Unit&) const {}
    __device__ __forceinline__ void done(const Unit&) const {}
};

typedef float f32x2_t __attribute__((ext_vector_type(2))); typedef __bf16 bf16x2_t __attribute__((ext_vector_type(2)));
__device__ __forceinline__ unsigned cvt_pk_bf16(float lo, float hi) { const f32x2_t v = {lo, hi}; const bf16x2_t b = __builtin_convertvector(v, bf16x2_t); return __builtin_bit_cast(unsigned, b); }
__device__ __forceinline__ u32x4 pack8(const f32x4 v0, const f32x4 v1) { u32x4 w; w.x = cvt_pk_bf16(v0[0], v0[1]); w.y = cvt_pk_bf16(v0[2], v0[3]); w.z = cvt_pk_bf16(v1[0], v1[1]); w.w = cvt_pk_bf16(v1[2], v1[3]); return w; }
__device__ __forceinline__ float bflo(unsigned w) { return __uint_as_float(w << 16); }
__device__ __forceinline__ float bfhi(unsigned w) { return __uint_as_float(w & 0xffff0000u); }
__device__ __forceinline__ float sigm(float x) { return __builtin_amdgcn_rcpf(1.0f + __builtin_amdgcn_exp2f(-1.44269504089f * x)); }
constexpr float SS_SCALE = 1048576.0f;
__device__ __forceinline__ float rstd_from(const unsigned long long* ss, int row, float eps) { return rsqrtf((float)ss[row] * (1.0f / (SS_SCALE * 4096.0f)) + eps); }
constexpr float RMS_EPS = 1e-6f;
struct RowScales { float rs[8]; int pm;
    __device__ __forceinline__ void load(const unsigned long long* ss, int pm_, int wid, int lane, float mul) { pm = pm_; const int row0 = pm_ * BM + (wid >> 2) * 64 + (lane & 15);
#pragma unroll
        for (int j = 0; j < 8; ++j) rs[j] = rstd_from(ss, row0 + (j >> 2) * HALF + (j & 3) * 16, RMS_EPS) * mul; }
    __device__ __forceinline__ float get(const unsigned long long* ss, const Unit& u, int ai, int m, int row, float mul) const { return u.pm == pm ? rs[ai * 4 + m] : rstd_from(ss, row, RMS_EPS) * mul; }
};

__device__ __forceinline__ unsigned pk4_fp8(float a, float b, float c, float d) { int w = 0; w = __builtin_amdgcn_cvt_pk_fp8_f32(a, b, w, false); w = __builtin_amdgcn_cvt_pk_fp8_f32(c, d, w, true); return (unsigned)w; }
template <bool H8> struct EpiSwigluT {
    static constexpr bool PERM = true, AFTER_DRAIN = false;
    bf16_t* H; const unsigned long long* ss; RowScales R; float mul;
    __device__ __forceinline__ void operator()(const f32x4 (&acc)[2][2][4][2], const Unit& u, int wr, int wc, int fr_, int fq_) const {
        const int fr = launder_v(fr_), fq = launder_v(fq_);
        const int row0 = u.pm * BM + wr * 64 + fr, col0 = u.pn * HALF + wc * 32 + 8 * fq;
#pragma unroll
        for (int ai = 0; ai < 2; ++ai)
#pragma unroll
            for (int m = 0; m < 4; ++m) { const int row = row0 + ai * HALF + m * 16; const float rs = R.get(ss, u, ai, m, row, mul), rl = rs * -1.44269504089f, iq = __builtin_amdgcn_rcpf(rs * rs);
                f32x4 h[2];
#pragma unroll
                for (int n = 0; n < 2; ++n)
#pragma unroll
                    for (int i = 0; i < 4; ++i) { const float ag = acc[ai][0][m][n][i]; h[n][i] = (ag * acc[ai][1][m][n][i]) * __builtin_amdgcn_rcpf(__builtin_fmaf(__builtin_amdgcn_exp2f(ag * rl), iq, iq)); }
                if constexpr (H8) { typedef unsigned u32x2 __attribute__((ext_vector_type(2))); u32x2 w8; w8.x = pk4_fp8(h[0][0], h[0][1], h[0][2], h[0][3]); w8.y = pk4_fp8(h[1][0], h[1][1], h[1][2], h[1][3]);
                    *(u32x2*)((unsigned char*)H + (size_t)row * 4096 + col0) = w8; }
                else *(u32x4*)(H + (size_t)row * 4096 + col0) = pack8(h[0], h[1]); }
    }
};
typedef EpiSwigluT<false> EpiSwiglu;
__device__ __forceinline__ void unpack8(const u32x4 w, f32x4& v0, f32x4& v1) { v0[0] = bflo(w.x); v0[1] = bfhi(w.x); v0[2] = bflo(w.y); v0[3] = bfhi(w.y); v1[0] = bflo(w.z); v1[1] = bfhi(w.z); v1[2] = bflo(w.w); v1[3] = bfhi(w.w); }
template <bool EMIT8> struct EpiResid {
    static constexpr bool PERM = true, AFTER_DRAIN = false;
    const float* base_f32; bf16_t* xb; unsigned long long* ss_out; float scale; long x8_delta;
    __device__ __forceinline__ void operator()(const f32x4 (&acc)[2][2][4][2], const Unit& u, int wr, int wc, int fr_, int fq_) const {
        const int fr = launder_v(fr_), fq = launder_v(fq_);
        const int row0 = u.pm * BM + wr * 64 + fr, col0 = u.pn * BM + wc * 32 + 8 * fq;
        if (base_f32) {
#pragma unroll
            for (int ai = 0; ai < 2; ++ai)
#pragma unroll
                for (int m = 0; m < 4; ++m) { const int row = row0 + ai * HALF + m * 16; float s = 0.f;
#pragma unroll
                    for (int bj = 0; bj < 2; ++bj) { const size_t off = (size_t)row * 4096 + col0 + bj * HALF;
                        const f32x4 b0 = *(const f32x4*)(base_f32 + off), b1 = *(const f32x4*)(base_f32 + off + 4);
                        const f32x4 v0 = b0 + acc[ai][bj][m][0] * scale, v1 = b1 + acc[ai][bj][m][1] * scale;
                        *(u32x4*)(xb + off) = pack8(v0, v1);
                        if constexpr (EMIT8) { typedef unsigned u32x2 __attribute__((ext_vector_type(2))); u32x2 w8; w8.x = pk4_fp8(v0[0], v0[1], v0[2], v0[3]); w8.y = pk4_fp8(v1[0], v1[1], v1[2], v1[3]); *(u32x2*)((unsigned char*)xb + x8_delta + off) = w8; }
                        s += (v0[0] * v0[0] + v0[1] * v0[1]) + (v0[2] * v0[2] + v0[3] * v0[3]) + (v1[0] * v1[0] + v1[1] * v1[1]) + (v1[2] * v1[2] + v1[3] * v1[3]); }
                    s += xor_lt32<16>(s); s = sum32(s);
                    if (fq == 0) atomicAdd(ss_out + row, (unsigned long long)(s * SS_SCALE + 0.5f));
                    if (m == 3) asm volatile("" ::: "memory"); }
            return;
        }
        u32x4 xr[2][4][2];
#define RES_LD(ai, m) do { _Pragma("unroll") for (int bj = 0; bj < 2; ++bj) xr[ai][m][bj] = *(const u32x4*)(xb + (size_t)(row0 + (ai) * HALF + (m) * 16) * 4096 + col0 + bj * HALF); } while (0)
        RES_LD(0, 0); RES_LD(0, 1); RES_LD(0, 2); RES_LD(0, 3); RES_LD(1, 0); RES_LD(1, 1);
        asm volatile("" ::: "memory");
#pragma unroll
        for (int ai = 0; ai < 2; ++ai)
#pragma unroll
            for (int m = 0; m < 4; ++m) { const int row = row0 + ai * HALF + m * 16; float s = 0.f;
#pragma unroll
                for (int bj = 0; bj < 2; ++bj) { const size_t off = (size_t)row * 4096 + col0 + bj * HALF;
                    f32x4 b0, b1; unpack8(xr[ai][m][bj], b0, b1);
                    const f32x4 v0 = b0 + acc[ai][bj][m][0] * scale, v1 = b1 + acc[ai][bj][m][1] * scale;
                    *(u32x4*)(xb + off) = pack8(v0, v1);
                    if constexpr (EMIT8) { typedef unsigned u32x2 __attribute__((ext_vector_type(2))); u32x2 w8; w8.x = pk4_fp8(v0[0], v0[1], v0[2], v0[3]); w8.y = pk4_fp8(v1[0], v1[1], v1[2], v1[3]); *(u32x2*)((unsigned char*)xb + x8_delta + off) = w8; }
                    s += (v0[0] * v0[0] + v0[1] * v0[1]) + (v0[2] * v0[2] + v0[3] * v0[3]) + (v1[0] * v1[0] + v1[1] * v1[1]) + (v1[2] * v1[2] + v1[3] * v1[3]); }
                s += xor_lt32<16>(s); s = sum32(s);
                if (fq == 0) atomicAdd(ss_out + row, (unsigned long long)(s * SS_SCALE + 0.5f));
                if (ai == 0 && m == 1) { asm volatile("" ::: "memory"); RES_LD(1, 2); RES_LD(1, 3); asm volatile("" ::: "memory"); } }
#undef RES_LD
    }
};
struct EpiQKVG {
    static constexpr bool PERM = true, AFTER_DRAIN = false;
    bf16_t* qkv; bf16_t* gates; const unsigned long long* ss; const float* cosA; const float* sinA; const float* cosC; const float* sinC; RowScales R;
    __device__ __forceinline__ void operator()(const f32x4 (&acc)[2][2][4][2], const Unit& u, int wr, int wc, int fr_, int fq_) const {
        const int fr = launder_v(fr_), fq = launder_v(fq_);
        constexpr size_t MM = 16384;
        const int row0 = u.pm * BM + wr * 64 + fr; const int pn = u.pn;
        bf16_t* const QA = qkv; bf16_t* const KA = QA + MM * 2048; bf16_t* const VA = KA + MM * 512; bf16_t* const QB = VA + MM * 512; bf16_t* const KB = QB + MM * 1024; bf16_t* const VB = KB + MM * 1024;
        bf16_t* const QC = VB + MM * 1024; bf16_t* const KC = QC + MM * 1024; bf16_t* const VC = KC + MM * 1024;
        constexpr float L2E = 1.44269504089f;
        if (pn >= 36) {
            const int col0 = (pn - 36) * BM + wc * 32 + 8 * fq;
#pragma unroll
            for (int ai = 0; ai < 2; ++ai)
#pragma unroll
                for (int m = 0; m < 4; ++m) { const int row = row0 + ai * HALF + m * 16; const float rs = rstd_from(ss, row, RMS_EPS);
#pragma unroll
                    for (int bj = 0; bj < 2; ++bj) { f32x4 v0, v1;
#pragma unroll
                        for (int i = 0; i < 4; ++i) { v0[i] = sigm(acc[ai][bj][m][0][i] * rs); v1[i] = sigm(acc[ai][bj][m][1][i] * rs); }
                        *(u32x4*)(gates + (size_t)row * 12288 + col0 + bj * HALF) = pack8(v0, v1); } }
        } else if (pn < 10 || (pn >= 24 && pn < 32)) {
            const bool isA = pn < 10;
            bf16_t* dst; int ld, hcol, idx0, half; const float* ct; const float* st; float sc;
            if (isA) { const bool q = pn < 8; const int t = q ? pn : pn - 8; dst = q ? QA : KA; ld = q ? 2048 : 512; hcol = (2 * t + (wc >> 1)) * 128; idx0 = 32 * (wc & 1) + 8 * fq; half = 64; ct = cosA; st = sinA; sc = q ? 0.08838834764831845f * L2E : 1.0f; }
            else { const bool q = pn < 28; const int t = (pn - 24) & 3; dst = q ? QC : KC; ld = 1024; hcol = (4 * t + wc) * 64; idx0 = 8 * fq; half = 32; ct = cosC; st = sinC; sc = q ? 0.125f * L2E : 1.0f; }
#pragma unroll
            for (int ai = 0; ai < 2; ++ai)
#pragma unroll
                for (int m = 0; m < 4; ++m) { const int row = row0 + ai * HALF + m * 16; const float rs = R.get(ss, u, ai, m, row, 1.0f); const int pos = row & 4095;
                    const float* cp = ct + (size_t)pos * half + idx0; const float* sp = st + (size_t)pos * half + idx0;
                    const f32x4 c0 = *(const f32x4*)cp, c1 = *(const f32x4*)(cp + 4), s0 = *(const f32x4*)sp, s1 = *(const f32x4*)(sp + 4);
                    const f32x4 a0 = acc[ai][0][m][0] * rs, a1 = acc[ai][0][m][1] * rs, b0 = acc[ai][1][m][0] * rs, b1 = acc[ai][1][m][1] * rs;
                    const f32x4 y10 = (a0 * c0 - b0 * s0) * sc, y11 = (a1 * c1 - b1 * s1) * sc, y20 = (b0 * c0 + a0 * s0) * sc, y21 = (b1 * c1 + a1 * s1) * sc;
                    bf16_t* rp = dst + (size_t)row * ld + hcol + idx0;
                    *(u32x4*)rp = pack8(y10, y11); *(u32x4*)(rp + half) = pack8(y20, y21); }
        } else {
            bf16_t* dst; int ld, t0; float sc = 1.0f;
            if (pn < 12) { dst = VA; ld = 512; t0 = 10; } else if (pn < 16) { dst = QB; ld = 1024; t0 = 12; sc = 0.08838834764831845f * L2E; } else if (pn < 20) { dst = KB; ld = 1024; t0 = 16; }
            else if (pn < 24) { dst = VB; ld = 1024; t0 = 20; } else { dst = VC; ld = 1024; t0 = 32; }
            const int col0 = (pn - t0) * BM + wc * 32 + 8 * fq;
#pragma unroll
            for (int ai = 0; ai < 2; ++ai)
#pragma unroll
                for (int m = 0; m < 4; ++m) { const int row = row0 + ai * HALF + m * 16; const float rs = R.get(ss, u, ai, m, row, 1.0f) * sc;
#pragma unroll
                    for (int bj = 0; bj < 2; ++bj) *(u32x4*)(dst + (size_t)row * ld + col0 + bj * HALF) = pack8(acc[ai][bj][m][0] * rs, acc[ai][bj][m][1] * rs); }
        }
    }
};
struct EpiGates {
    static constexpr bool PERM = true, AFTER_DRAIN = false;
    unsigned char* gates; const unsigned long long* ss; RowScales R;
    __device__ __forceinline__ void operator()(const f32x4 (&acc)[2][2][4][2], const Unit& u, int wr, int wc, int fr_, int fq_) const {
        const int fr = launder_v(fr_), fq = launder_v(fq_);
        const int row0 = u.pm * BM + wr * 64 + fr;
        u32x4* rec = (u32x4*)gates + ((size_t)(u.pm * 48 + u.pn) * 8 + (wr * 4 + wc)) * 8 * 64 + (fq * 16 + fr);
#pragma unroll
        for (int ai = 0; ai < 2; ++ai)
#pragma unroll
            for (int m = 0; m < 4; ++m) { const int row = row0 + ai * HALF + m * 16; const float rs = R.get(ss, u, ai, m, row, 1.0f / 64.0f) * -1.44269504089f;
                u32x4 w;
#pragma unroll
                for (int bj = 0; bj < 2; ++bj) { unsigned q[8];
#pragma unroll
                    for (int i = 0; i < 4; ++i) {
                        q[i] = __float_as_uint(__builtin_amdgcn_rcpf(__builtin_amdgcn_fmed3f(__builtin_fmaf(__builtin_amdgcn_exp2f(acc[ai][bj][m][0][i] * rs), 1.0f / 255.0f, 1.0f / 255.0f), 0.0f, 1.0f)) + 8388608.0f);
                        q[4 + i] = __float_as_uint(__builtin_amdgcn_rcpf(__builtin_amdgcn_fmed3f(__builtin_fmaf(__builtin_amdgcn_exp2f(acc[ai][bj][m][1][i] * rs), 1.0f / 255.0f, 1.0f / 255.0f), 0.0f, 1.0f)) + 8388608.0f); }
                    const unsigned lo = __builtin_amdgcn_perm(q[1], q[0], 0x0c0c0400u) | __builtin_amdgcn_perm(q[3], q[2], 0x04000c0cu), hi = __builtin_amdgcn_perm(q[5], q[4], 0x0c0c0400u) | __builtin_amdgcn_perm(q[7], q[6], 0x04000c0cu);
                    if (bj == 0) { w.x = lo; w.y = hi; } else { w.z = lo; w.w = hi; } }
                rec[(ai * 4 + m) * 64] = w; }
    }
};
struct EpiMerge {
    static constexpr bool PERM = true, AFTER_DRAIN = false;
    const unsigned char* gates; bf16_t* mb; int mode;
    __device__ __forceinline__ void operator()(const f32x4 (&acc)[2][2][4][2], const Unit& u, int wr, int wc, int fr_, int fq_) const {
        const int fr = launder_v(fr_), fq = launder_v(fq_);
        const int row0 = u.pm * BM + wr * 64 + fr, col0 = u.pn * BM + wc * 32 + 8 * fq;
#pragma unroll
        for (int ai = 0; ai < 2; ++ai)
#pragma unroll
            for (int m = 0; m < 4; ++m) { const int row = row0 + ai * HALF + m * 16;
#pragma unroll
                for (int bj = 0; bj < 2; ++bj) { const size_t off = (size_t)row * 4096 + col0 + bj * HALF;
                    typedef unsigned u32x2 __attribute__((ext_vector_type(2))); const u32x2 gw = *(const u32x2*)(gates + (size_t)row * 12288 + col0 + bj * HALF);
                    f32x4 v0, v1; v0[0] = (float)(gw.x & 0xffu); v0[1] = (float)((gw.x >> 8) & 0xffu); v0[2] = (float)((gw.x >> 16) & 0xffu); v0[3] = (float)(gw.x >> 24);
                    v1[0] = (float)(gw.y & 0xffu); v1[1] = (float)((gw.y >> 8) & 0xffu); v1[2] = (float)((gw.y >> 16) & 0xffu); v1[3] = (float)(gw.y >> 24);
                    v0 = v0 * acc[ai][bj][m][0] * (1.0f / 255.0f); v1 = v1 * acc[ai][bj][m][1] * (1.0f / 255.0f);
                    if (mode != 0) { f32x4 p0, p1; unpack8(*(const u32x4*)(mb + off), p0, p1); v0 = v0 + p0; v1 = v1 + p1; }
                    *(u32x4*)(mb + off) = pack8(v0, v1); }
                if (m == 3) asm volatile("" ::: "memory"); }
    }
};

typedef int v8i32 __attribute__((ext_vector_type(8))); typedef int v4i32 __attribute__((ext_vector_type(4)));
__device__ __forceinline__ v8i32 cat8(const bf16x8 lo, const bf16x8 hi) { const v4i32 a = __builtin_bit_cast(v4i32, lo), b = __builtin_bit_cast(v4i32, hi); return __builtin_shufflevector(a, b, 0, 1, 2, 3, 4, 5, 6, 7); }
template <class Epi, class Sched, bool ALIGN_EPI = false, bool SP2 = false, bool FP8 = false>
__device__ __forceinline__ void gemm_phase(PG8_LAS unsigned char* lds, const Gemm g, const Sched& S, const Epi& E, int wid) {
    const int lane = lane_id(), tid = wid * 64 + lane, wr = wid >> 2, wc = wid & 3, fr = lane & 15, fq = lane >> 4;
    const int K = g.K, nt = K / BK;
    unsigned voffA[2], voffB[2];
#pragma unroll
    for (int i = 0; i < 2; ++i) { int R, C; stage_rc(tid * 16 + i * 8192, R, C); const int Rb = Epi::PERM ? ((R & ~31) + perm32(R & 31)) : R;
        voffA[i] = (unsigned)(R * K + C) * 2u; voffB[i] = (unsigned)(Rb * K + C) * 2u; }
    const size_t kstep = (size_t)(BK * 2);
    const size_t hstep = (size_t)HALF * K * 2;
    const size_t tstep = 2 * hstep;
    const unsigned ldsw = (unsigned)wid * 1024u;
    const int aoff = lds_byte(wr * 64 + fr, fq * 8), boff = lds_byte(wc * 32 + fr, fq * 8);
#define PG8_SA(b, h) (((b) * 2 + (h)) * HTB)
#define PG8_SB(b, h) ((4 + (b) * 2 + (h)) * HTB)
#define PG8_STAGE(bufoff, gbase, voff) do { _Pragma("unroll") for (int _i = 0; _i < 2; ++_i) \
        __builtin_amdgcn_global_load_lds((const unsigned*)((const char*)(gbase) + (voff)[_i]), (PG8_LAS unsigned*)(lds + (bufoff) + ldsw + _i * 8192), 16, 0, 0); } while (0)
#define PG8_LDA(dst, b, h) do { _Pragma("unroll") for (int m = 0; m < 4; ++m) _Pragma("unroll") for (int k = 0; k < 2; ++k) dst[m][k] = *(const PG8_LAS bf16x8*)(lds + PG8_SA(b, h) + aoff + m * 2048 + k * 1024); } while (0)
#define PG8_LDB(dst, b, h) do { _Pragma("unroll") for (int n = 0; n < 2; ++n) _Pragma("unroll") for (int k = 0; k < 2; ++k) dst[n][k] = *(const PG8_LAS bf16x8*)(lds + PG8_SB(b, h) + boff + n * 2048 + k * 1024); } while (0)
#define PG8_MMA(ai, bj, At, Bt) do { __builtin_amdgcn_s_setprio(1); _Pragma("unroll") for (int m = 0; m < 4; ++m) _Pragma("unroll") for (int n = 0; n < 2; ++n) { \
        if constexpr (FP8) { asm volatile("v_mfma_scale_f32_16x16x128_f8f6f4 %0, %1, %2, %0, %3, %3 op_sel_hi:[0,0,0]" : "+v"(acc[ai][bj][m][n]) : "v"(cat8(Bt[n][0], Bt[n][1])), "v"(cat8(At[m][0], At[m][1])), "v"(0x7f7f7f7f)); } \
        else { _Pragma("unroll") for (int k = 0; k < 2; ++k) acc[ai][bj][m][n] = __builtin_amdgcn_mfma_f32_16x16x32_bf16(Bt[n][k], At[m][k], acc[ai][bj][m][n], 0, 0, 0); } } __builtin_amdgcn_s_setprio(0); } while (0)
#define PG8_WAIT_V(n) asm volatile("s_waitcnt vmcnt(" #n ")" ::: "memory")
#define PG8_WAIT_L(n) asm volatile("s_waitcnt lgkmcnt(" #n ")" ::: "memory")
#define PG8_BAR __builtin_amdgcn_s_barrier()
#define PG8_SCHED __builtin_amdgcn_sched_barrier(0)
    Unit cur, nxt; int ui = 0;
    if (!S.next(0, cur)) return;
    f32x4 acc[2][2][4][2];
#pragma unroll
    for (int a = 0; a < 2; ++a)
#pragma unroll
        for (int b = 0; b < 2; ++b)
#pragma unroll
            for (int m = 0; m < 4; ++m)
#pragma unroll
                for (int n = 0; n < 2; ++n) acc[a][b][m][n] = (f32x4){0.f, 0.f, 0.f, 0.f};
    bf16x8 At[4][2], B0[2][2], B1[2][2];
    const char* cA = (const char*)g.A + (size_t)cur.pm * tstep; const char* cB = (const char*)g.Bt + (size_t)cur.pn * tstep;
    S.a_ready(cur);
    if constexpr (SP2) {
        PG8_STAGE(PG8_SB(0, 0), cB, voffB); PG8_STAGE(PG8_SB(0, 1), cB + hstep, voffB); PG8_STAGE(PG8_SA(0, 0), cA, voffA); PG8_STAGE(PG8_SA(0, 1), cA + hstep, voffA);
        if (wr == 1) PG8_BAR;
        PG8_WAIT_V(2); PG8_BAR;
        PG8_STAGE(PG8_SB(1, 0), cB + kstep, voffB); PG8_STAGE(PG8_SA(1, 0), cA + kstep, voffA); PG8_STAGE(PG8_SB(1, 1), cB + hstep + kstep, voffB);
        PG8_WAIT_V(6); PG8_BAR;
    } else {
        PG8_STAGE(PG8_SB(0, 0), cB, voffB); PG8_STAGE(PG8_SA(0, 0), cA, voffA); PG8_STAGE(PG8_SB(0, 1), cB + hstep, voffB); PG8_STAGE(PG8_SA(0, 1), cA + hstep, voffA);
        if (wr == 1) PG8_BAR;
        PG8_WAIT_V(4); PG8_BAR;
        PG8_STAGE(PG8_SB(1, 0), cB + kstep, voffB); PG8_STAGE(PG8_SA(1, 0), cA + kstep, voffA); PG8_STAGE(PG8_SB(1, 1), cB + hstep + kstep, voffB);
        PG8_WAIT_V(6); PG8_BAR;
    }
    for (;;) {
        const bool has_next = S.next(ui + 1, nxt);
        const char* nA = has_next ? (const char*)g.A + (size_t)nxt.pm * tstep : cA; const char* nB = has_next ? (const char*)g.Bt + (size_t)nxt.pn * tstep : cB;
        for (int t = 0; t < nt; t += 2) {
            const bool last = (t == nt - 2);
            const char* a1 = cA + (size_t)(t + 1) * kstep;
            const char* a2 = last ? nA : cA + (size_t)(t + 2) * kstep; const char* b2 = last ? nB : cB + (size_t)(t + 2) * kstep;
            const char* a3 = a2 + kstep; const char* b3 = b2 + kstep;
            if (last && has_next) S.a_ready(nxt);
            if constexpr (SP2) {
            PG8_LDB(B0, 0, 0); PG8_LDB(B1, 0, 1); PG8_SCHED; PG8_LDA(At, 0, 0); PG8_STAGE(PG8_SA(1, 1), a1 + hstep, voffA);
            PG8_WAIT_V(8); PG8_WAIT_L(0); PG8_BAR; PG8_MMA(0, 0, At, B0); PG8_MMA(0, 1, At, B1); PG8_BAR; PG8_SCHED;
            PG8_LDA(At, 0, 1); PG8_STAGE(PG8_SB(0, 0), b2, voffB); PG8_STAGE(PG8_SB(0, 1), b2 + hstep, voffB); PG8_STAGE(PG8_SA(0, 0), a2, voffA);
            PG8_WAIT_V(8); PG8_WAIT_L(0); PG8_BAR; PG8_MMA(1, 0, At, B0); PG8_MMA(1, 1, At, B1); PG8_BAR; PG8_SCHED;
            PG8_LDB(B0, 1, 0); PG8_LDB(B1, 1, 1); PG8_SCHED; PG8_LDA(At, 1, 0); PG8_STAGE(PG8_SA(0, 1), a2 + hstep, voffA);
            PG8_WAIT_V(8); PG8_WAIT_L(0); PG8_BAR; PG8_MMA(0, 0, At, B0); PG8_MMA(0, 1, At, B1); PG8_BAR; PG8_SCHED;
            PG8_LDA(At, 1, 1); PG8_STAGE(PG8_SB(1, 0), b3, voffB); PG8_STAGE(PG8_SB(1, 1), b3 + hstep, voffB); PG8_STAGE(PG8_SA(1, 0), a3, voffA);
            PG8_WAIT_V(8); PG8_WAIT_L(0); PG8_BAR; PG8_MMA(1, 0, At, B0); PG8_MMA(1, 1, At, B1); PG8_BAR; PG8_SCHED;
            } else {
            PG8_LDB(B0, 0, 0); PG8_SCHED; PG8_LDA(At, 0, 0); PG8_STAGE(PG8_SA(1, 1), a1 + hstep, voffA);
            PG8_WAIT_L(8); PG8_BAR; PG8_WAIT_L(0); PG8_MMA(0, 0, At, B0); PG8_BAR; PG8_SCHED;
            PG8_LDB(B1, 0, 1); PG8_STAGE(PG8_SB(0, 0), b2, voffB);
            PG8_BAR; PG8_WAIT_L(0); PG8_MMA(0, 1, At, B1); PG8_BAR;
            PG8_LDA(At, 0, 1); PG8_STAGE(PG8_SA(0, 0), a2, voffA);
            PG8_BAR; PG8_WAIT_L(0); PG8_MMA(1, 0, At, B0); PG8_BAR; PG8_SCHED;
            PG8_STAGE(PG8_SB(0, 1), b2 + hstep, voffB);
            PG8_WAIT_V(6); PG8_BAR; PG8_MMA(1, 1, At, B1); PG8_BAR;
            PG8_LDB(B0, 1, 0); PG8_SCHED; PG8_LDA(At, 1, 0); PG8_STAGE(PG8_SA(0, 1), a2 + hstep, voffA);
            PG8_WAIT_L(8); PG8_BAR; PG8_WAIT_L(0); PG8_MMA(0, 0, At, B0); PG8_BAR; PG8_SCHED;
            PG8_LDB(B1, 1, 1); PG8_STAGE(PG8_SB(1, 0), b3, voffB);
            PG8_BAR; PG8_WAIT_L(0); PG8_MMA(0, 1, At, B1); PG8_BAR;
            PG8_LDA(At, 1, 1); PG8_STAGE(PG8_SA(1, 0), a3, voffA);
            PG8_BAR; PG8_WAIT_L(0); PG8_MMA(1, 0, At, B0); PG8_BAR; PG8_SCHED;
            PG8_STAGE(PG8_SB(1, 1), b3 + hstep, voffB);
            PG8_WAIT_V(6); PG8_BAR; PG8_MMA(1, 1, At, B1); PG8_BAR;
            }
        }
        if constexpr (ALIGN_EPI) { if (wr == 0) PG8_BAR; }
        if constexpr (FP8) asm volatile("s_nop 15\n\ts_nop 15" ::: "memory");
        if constexpr (!Epi::AFTER_DRAIN) { E(acc, cur, wr, wc, fr, fq); S.done(cur); }
        if (!has_next) break;
#pragma unroll
        for (int a = 0; a < 2; ++a)
#pragma unroll
            for (int b = 0; b < 2; ++b)
#pragma unroll
                for (int m = 0; m < 4; ++m)
#pragma unroll
                    for (int n = 0; n < 2; ++n) acc[a][b][m][n] = (f32x4){0.f, 0.f, 0.f, 0.f};
        cur = nxt; cA = nA; cB = nB; ++ui;
        if constexpr (ALIGN_EPI) { if (wr == 1) PG8_BAR; }
    }
    PG8_WAIT_V(0);
    if constexpr (!ALIGN_EPI) { if (wr == 0) PG8_BAR; }
    PG8_BAR;
#undef PG8_SA
#undef PG8_SB
#undef PG8_STAGE
#undef PG8_LDA
#undef PG8_LDB
#undef PG8_MMA
#undef PG8_WAIT_V
#undef PG8_WAIT_L
#undef PG8_BAR
#undef PG8_SCHED
}

struct MergeGemm { const bf16_t* Aa; const bf16_t* Abc; const bf16_t* Ba; const bf16_t* Bbc; const unsigned char* gates; bf16_t* mb; };
__device__ __forceinline__ void unpack_u8(const unsigned w, float (&f)[4]) { f[0] = (float)(w & 0xffu); f[1] = (float)((w >> 8) & 0xffu); f[2] = (float)((w >> 16) & 0xffu); f[3] = (float)(w >> 24); }
template <class Sched>
__device__ __forceinline__ void gemm_phase_merge(PG8_LAS unsigned char* lds, const MergeGemm g, const Sched& S, int wid) {
    constexpr int K = 2048;
    const int lane = lane_id(), tid = wid * 64 + lane, wr = wid >> 2, wc = wid & 3, fr = lane & 15, fq = lane >> 4;
    unsigned voffA[2], voffB[2];
#pragma unroll
    for (int i = 0; i < 2; ++i) { int R, C; stage_rc(tid * 16 + i * 8192, R, C); const int Rb = (R & ~31) + perm32(R & 31);
        voffA[i] = (unsigned)(R * K + C) * 2u; voffB[i] = (unsigned)(Rb * K + C) * 2u; }
    const size_t kstep = (size_t)(BK * 2);
    const size_t hstep = (size_t)HALF * K * 2;
    const size_t tstep = 2 * hstep;
    const unsigned ldsw = (unsigned)wid * 1024u;
    const int aoff = lds_byte(wr * 64 + fr, fq * 8), boff = lds_byte(wc * 32 + fr, fq * 8);
#define PG8_SA(b, h) (((b) * 2 + (h)) * HTB)
#define PG8_SB(b, h) ((4 + (b) * 2 + (h)) * HTB)
#define PG8_STAGE(bufoff, gbase, voff) do { _Pragma("unroll") for (int _i = 0; _i < 2; ++_i) \
        __builtin_amdgcn_global_load_lds((const unsigned*)((const char*)(gbase) + (voff)[_i]), (PG8_LAS unsigned*)(lds + (bufoff) + ldsw + _i * 8192), 16, 0, 0); } while (0)
#define PG8_LDA(dst, b, h) do { _Pragma("unroll") for (int m = 0; m < 4; ++m) _Pragma("unroll") for (int k = 0; k < 2; ++k) dst[m][k] = *(const PG8_LAS bf16x8*)(lds + PG8_SA(b, h) + aoff + m * 2048 + k * 1024); } while (0)
#define PG8_LDB(dst, b, h) do { _Pragma("unroll") for (int n = 0; n < 2; ++n) _Pragma("unroll") for (int k = 0; k < 2; ++k) dst[n][k] = *(const PG8_LAS bf16x8*)(lds + PG8_SB(b, h) + boff + n * 2048 + k * 1024); } while (0)
#define PG8_MMA(ai, bj, At, Bt) do { __builtin_amdgcn_s_setprio(1); _Pragma("unroll") for (int m = 0; m < 4; ++m) _Pragma("unroll") for (int n = 0; n < 2; ++n) _Pragma("unroll") for (int k = 0; k < 2; ++k) \
        acc[ai][bj][m][n] = __builtin_amdgcn_mfma_f32_16x16x32_bf16(Bt[n][k], At[m][k], acc[ai][bj][m][n], 0, 0, 0); __builtin_amdgcn_s_setprio(0); } while (0)
#define PG8_WAIT_V(n) asm volatile("s_waitcnt vmcnt(" #n ")" ::: "memory")
#define PG8_WAIT_L(n) asm volatile("s_waitcnt lgkmcnt(" #n ")" ::: "memory")
#define PG8_BAR __builtin_amdgcn_s_barrier()
#define PG8_SCHED __builtin_amdgcn_sched_barrier(0)
#define MG_A(pm, br) ((const char*)((br) == 0 ? g.Aa : g.Abc + ((br) == 2 ? 1024 : 0)) + (size_t)(pm) * tstep)
#define MG_B(pn, br) ((const char*)((br) == 0 ? g.Ba : g.Bbc + ((br) == 2 ? 1024 : 0)) + (size_t)(pn) * tstep)
    Unit cur, nu; int ui = 0, br = 0;
    if (!S.next(0, cur)) return;
    f32x4 acc[2][2][4][2];
#pragma unroll
    for (int a = 0; a < 2; ++a)
#pragma unroll
        for (int b = 0; b < 2; ++b)
#pragma unroll
            for (int m = 0; m < 4; ++m)
#pragma unroll
                for (int n = 0; n < 2; ++n) acc[a][b][m][n] = (f32x4){0.f, 0.f, 0.f, 0.f};
    bf16x8 At[4][2], B0[2][2], B1[2][2];
    const char* cA = MG_A(cur.pm, 0); const char* cB = MG_B(cur.pn, 0);
    PG8_STAGE(PG8_SB(0, 0), cB, voffB); PG8_STAGE(PG8_SB(0, 1), cB + hstep, voffB); PG8_STAGE(PG8_SA(0, 0), cA, voffA); PG8_STAGE(PG8_SA(0, 1), cA + hstep, voffA);
    if (wr == 1) PG8_BAR;
    PG8_WAIT_V(2); PG8_BAR;
    PG8_STAGE(PG8_SB(1, 0), cB + kstep, voffB); PG8_STAGE(PG8_SA(1, 0), cA + kstep, voffA); PG8_STAGE(PG8_SB(1, 1), cB + hstep + kstep, voffB);
    PG8_WAIT_V(6); PG8_BAR;
    for (;;) {
        int nbr = br + 1; bool has_next = true; nu = cur;
        if (nbr == 3) { nbr = 0; has_next = S.next(ui + 1, nu); }
        const char* nA = has_next ? MG_A(nu.pm, nbr) : cA; const char* nB = has_next ? MG_B(nu.pn, nbr) : cB;
        const int nt = br == 0 ? 32 : 16;
        for (int t = 0; t < nt; t += 2) {
            const bool last = (t == nt - 2);
            const char* a1 = cA + (size_t)(t + 1) * kstep;
            const char* a2 = last ? nA : cA + (size_t)(t + 2) * kstep; const char* b2 = last ? nB : cB + (size_t)(t + 2) * kstep;
            const char* a3 = a2 + kstep; const char* b3 = b2 + kstep;
            PG8_LDB(B0, 0, 0); PG8_LDB(B1, 0, 1); PG8_SCHED; PG8_LDA(At, 0, 0); PG8_STAGE(PG8_SA(1, 1), a1 + hstep, voffA);
            PG8_WAIT_V(8); PG8_WAIT_L(0); PG8_BAR; PG8_MMA(0, 0, At, B0); PG8_MMA(0, 1, At, B1); PG8_BAR; PG8_SCHED;
            PG8_LDA(At, 0, 1); PG8_STAGE(PG8_SB(0, 0), b2, voffB); PG8_STAGE(PG8_SB(0, 1), b2 + hstep, voffB); PG8_STAGE(PG8_SA(0, 0), a2, voffA);
            PG8_WAIT_V(8); PG8_WAIT_L(0); PG8_BAR; PG8_MMA(1, 0, At, B0); PG8_MMA(1, 1, At, B1); PG8_BAR; PG8_SCHED;
            PG8_LDB(B0, 1, 0); PG8_LDB(B1, 1, 1); PG8_SCHED; PG8_LDA(At, 1, 0); PG8_STAGE(PG8_SA(0, 1), a2 + hstep, voffA);
            PG8_WAIT_V(8); PG8_WAIT_L(0); PG8_BAR; PG8_MMA(0, 0, At, B0); PG8_MMA(0, 1, At, B1); PG8_BAR; PG8_SCHED;
            PG8_LDA(At, 1, 1); PG8_STAGE(PG8_SB(1, 0), b3, voffB); PG8_STAGE(PG8_SB(1, 1), b3 + hstep, voffB); PG8_STAGE(PG8_SA(1, 0), a3, voffA);
            PG8_WAIT_V(8); PG8_WAIT_L(0); PG8_BAR; PG8_MMA(1, 0, At, B0); PG8_MMA(1, 1, At, B1); PG8_BAR; PG8_SCHED;
        }
        if (wr == 0) PG8_BAR;
        {
            const int fr2 = launder_v(fr), fq2 = launder_v(fq);
            const int row0 = cur.pm * BM + wr * 64 + fr2, col0 = cur.pn * BM + wc * 32 + 8 * fq2;
            const u32x4* rec = (const u32x4*)g.gates + ((size_t)(cur.pm * 48 + br * 16 + cur.pn) * 8 + wid) * 8 * 64 + (fq2 * 16 + fr2);
#pragma unroll
            for (int ai = 0; ai < 2; ++ai)
#pragma unroll
                for (int m = 0; m < 4; ++m) { const int row = row0 + ai * HALF + m * 16;
                    const u32x4 gc = rec[(ai * 4 + m) * 64];
                    if (br < 2) {
                        const u32x4 gn = rec[(size_t)16 * 8 * 8 * 64 + (ai * 4 + m) * 64];
#pragma unroll
                        for (int bj = 0; bj < 2; ++bj) { float c0[4], c1[4], n0[4], n1[4]; unpack_u8(bj ? gc.z : gc.x, c0); unpack_u8(bj ? gc.w : gc.y, c1); unpack_u8(bj ? gn.z : gn.x, n0); unpack_u8(bj ? gn.w : gn.y, n1);
#pragma unroll
                            for (int i = 0; i < 4; ++i) { acc[ai][bj][m][0][i] *= c0[i] * __builtin_amdgcn_rcpf(n0[i]); acc[ai][bj][m][1][i] *= c1[i] * __builtin_amdgcn_rcpf(n1[i]); } }
                    } else {
#pragma unroll
                        for (int bj = 0; bj < 2; ++bj) { float c0[4], c1[4]; unpack_u8(bj ? gc.z : gc.x, c0); unpack_u8(bj ? gc.w : gc.y, c1);
                            f32x4 v0, v1;
#pragma unroll
                            for (int i = 0; i < 4; ++i) { v0[i] = acc[ai][bj][m][0][i] * (c0[i] * (1.0f / 255.0f)); v1[i] = acc[ai][bj][m][1][i] * (c1[i] * (1.0f / 255.0f)); }
                            *(u32x4*)(g.mb + (size_t)row * 4096 + col0 + bj * HALF) = pack8(v0, v1); } }
                    if (m == 3) asm volatile("" ::: "memory"); }
        }
        if (!has_next) break;
        if (br == 2) {
#pragma unroll
            for (int a = 0; a < 2; ++a)
#pragma unroll
                for (int b = 0; b < 2; ++b)
#pragma unroll
                    for (int m = 0; m < 4; ++m)
#pragma unroll
                        for (int n = 0; n < 2; ++n) acc[a][b][m][n] = (f32x4){0.f, 0.f, 0.f, 0.f};
            ++ui; }
        cur = nu; br = nbr; cA = nA; cB = nB;
        if (wr == 1) PG8_BAR;
    }
    PG8_WAIT_V(0);
    PG8_BAR;
#undef MG_A
#undef MG_B
#undef PG8_SA
#undef PG8_SB
#undef PG8_STAGE
#undef PG8_LDA
#undef PG8_LDB
#undef PG8_MMA
#undef PG8_WAIT_V
#undef PG8_WAIT_L
#undef PG8_BAR
#undef PG8_SCHED
}
}

constexpr int NWAVES = 8;
constexpr int DM = 4096, SEQ = 4096, NBATCH = 4, DEPTH = 4, DFF = 4096;
constexpr int M = NBATCH * SEQ;
constexpr int NQKV = 9216, NGATE = 12288, NQG = NQKV + NGATE;
constexpr int NPH = 2 + 8 * DEPTH;

constexpr size_t MiB = 1u << 20;
constexpr size_t WS_CTL = 0, CTL_ZERO_BYTES = 4 * MiB;
constexpr int CW_TICKET = 8192;
constexpr int CW_BAR = 16384;
constexpr size_t WS_SS = 1 * MiB;
constexpr size_t WS_ROPE = 4 * MiB;
constexpr size_t WS_W = 8 * MiB, W_LAYER = 424 * MiB;
constexpr size_t WO_W1 = 0, WO_W2 = 64 * MiB, WO_QG = 96 * MiB, WO_A = 264 * MiB, WO_B = 280 * MiB, WO_C = 288 * MiB, WO_O = 296 * MiB, WO_W3 = 328 * MiB, WO_W4 = 392 * MiB;
constexpr size_t WS_XF = WS_W + 4 * W_LAYER;
constexpr size_t WS_WG8 = WS_XF, WG8_LAYER = 48 * MiB;
constexpr size_t WS_XB8 = WS_XF + 192 * MiB;
constexpr size_t WS_XB = WS_XF + 256 * MiB;
constexpr size_t WS_HID = WS_XB + 128 * MiB;
constexpr size_t WS_QKV = WS_HID + 128 * MiB;
constexpr size_t WS_GATES = WS_QKV + 288 * MiB;
constexpr size_t WS_OA = WS_GATES + 384 * MiB;
constexpr size_t WS_MERGED = WS_OA + 128 * MiB, WS_W3F8 = WS_MERGED, WS_W4F8 = WS_MERGED + 32 * MiB;
#define FFN2_FP8(l) ((l) == 3)
constexpr size_t WS_MB = WS_MERGED + 256 * MiB;
constexpr size_t WS_END = WS_MB + 128 * MiB;

constexpr int RING_OFF = 0, RING_BYTES = 131072;
constexpr int LDSCTL_OFF = RING_BYTES, MISC_OFF = LDSCTL_OFF + 320;
constexpr int LDS_BYTES = 147456;
static_assert(MISC_OFF + 128 <= LDS_BYTES, "LDS map");

#define GAS __attribute__((address_space(1)))
#define LAS __attribute__((address_space(3)))
typedef unsigned short bf16;
typedef unsigned v4u __attribute__((ext_vector_type(4)));
typedef float f32x4 __attribute__((ext_vector_type(4)));
typedef GAS unsigned gu32;
#define RLX_AGENT __ATOMIC_RELAXED, __HIP_MEMORY_SCOPE_AGENT
#define LDS_WAIT() asm volatile("s_waitcnt lgkmcnt(0)" ::: "memory")
#define VM_WAIT() asm volatile("s_waitcnt vmcnt(0)" ::: "memory")
__device__ __forceinline__ unsigned f2bf(float f) { unsigned u = __builtin_bit_cast(unsigned, f); return (u + 0x7fffu + ((u >> 16) & 1u)) >> 16; }
__device__ __forceinline__ unsigned pk2(float lo, float hi) { return f2bf(lo) | (f2bf(hi) << 16); }
__device__ __forceinline__ float bf_lo(unsigned w) { return __uint_as_float(w << 16); }
__device__ __forceinline__ float bf_hi(unsigned w) { return __uint_as_float(w & 0xffff0000u); }

#define XB_TMO      128
#define XB_XCNT(j)  (256  + 64 * (j))
#define XB_XSUB(j)  (1280 + 64 * (j))
#define XB_XGEN(j)  (2304 + 64 * (j))
#define XB_TOP      3328
#define XB_TOPGEN   3392
#define XCD_BAR_WORDS 3456
#define XB_SPIN_CAP (1u << 22)

__device__ __forceinline__ unsigned xb_ld(unsigned* p)              { return __hip_atomic_load(p, __ATOMIC_RELAXED, __HIP_MEMORY_SCOPE_AGENT); }
__device__ __forceinline__ unsigned xb_add(unsigned* p, unsigned v) { return __hip_atomic_fetch_add(p, v, __ATOMIC_RELAXED, __HIP_MEMORY_SCOPE_AGENT); }
__device__ __forceinline__ unsigned xb_xcc_id() { return (unsigned)__builtin_amdgcn_readfirstlane((int)((unsigned)__builtin_amdgcn_s_getreg((3 << 11) | 20) & 0xFu)); }
#define XB_SPIN(cond, bar) do { unsigned _sp = 0; while (cond) { __builtin_amdgcn_s_sleep(1); \
    if ((++_sp & 255u) == 0u) { if (xb_ld(&(bar)[XB_TMO])) break; if (_sp > XB_SPIN_CAP) { atomicAdd(&(bar)[XB_TMO], 1u); break; } } } } while (0)

struct XcdBarrier {
    unsigned* bar; unsigned x;
    volatile LAS unsigned* st;
};
__device__ __forceinline__ XcdBarrier xcd_barrier_post(unsigned* bar, volatile LAS unsigned* st) {
    XcdBarrier b; b.bar = bar; b.x = xb_xcc_id(); b.st = st;
    if (threadIdx.x == 0) (void)xb_add(&bar[XB_XCNT(b.x)], 1u);
    return b;
}
__device__ __forceinline__ void xcd_barrier_complete(unsigned* bar, unsigned x, unsigned& nloc, unsigned& nx) {
    const unsigned G = gridDim.x * gridDim.y * gridDim.z;
    unsigned sum, cnt, mine, sp = 0u;
    for (;;) {
        sum = 0u; cnt = 0u; mine = 0u;
#pragma unroll
        for (unsigned j = 0; j < 16; ++j) { const unsigned c = xb_ld(&bar[XB_XCNT(j)]); sum += c; cnt += (c > 0u) ? 1u : 0u; mine = (j == x) ? c : mine; }
        if (sum == G) break;
        __builtin_amdgcn_s_sleep(1);
        if ((++sp & 255u) == 0u) { if (xb_ld(&bar[XB_TMO])) break; if (sp > XB_SPIN_CAP) { atomicAdd(&bar[XB_TMO], 1u); break; } }
    }
    nloc = mine > 0u ? mine : 1u; nx = cnt > 0u ? cnt : 1u;
}
__device__ __forceinline__ void xcd_barrier(const XcdBarrier& b, int wave) {
    asm volatile("s_waitcnt vmcnt(0)" ::: "memory");
    __syncthreads();
    if (wave == 0 && pg8::lane_id() == 0) {
        unsigned* bar = b.bar; unsigned bx = b.x; asm volatile("" : "+s"(bx));
        __builtin_amdgcn_s_waitcnt(0);
        unsigned nloc = b.st[0], nx = b.st[1];
        if (nloc == 0u) { xcd_barrier_complete(bar, bx, nloc, nx); b.st[0] = nloc; b.st[1] = nx; }
        const unsigned old = xb_add(&bar[XB_XSUB(bx)], 1u);
        const unsigned gen = old / nloc;
        if (old + 1u == (gen + 1u) * nloc) {
            __builtin_amdgcn_fence(__ATOMIC_RELEASE, "agent");
            asm volatile("s_waitcnt vmcnt(0)" ::: "memory");
            const unsigned og = xb_add(&bar[XB_TOP], 1u);
            const unsigned tg = og / nx;
            if (og + 1u == (tg + 1u) * nx) xb_add(&bar[XB_TOPGEN], 1u);
            else XB_SPIN(xb_ld(&bar[XB_TOPGEN]) == tg, bar);
            __builtin_amdgcn_fence(__ATOMIC_ACQUIRE, "agent");
            xb_add(&bar[XB_XGEN(bx)], 1u);
            asm volatile("s_waitcnt vmcnt(0)" ::: "memory");
        } else {
            XB_SPIN(xb_ld(&bar[XB_XGEN(bx)]) == gen, bar);
            __builtin_amdgcn_fence(__ATOMIC_ACQUIRE, "agent");
            asm volatile("s_waitcnt vmcnt(0)" ::: "memory");
        }
    }
    __syncthreads();
}

struct Args { const float* in[21]; float* out; unsigned char* ws; int ph_lo, ph_hi, li, pad; };
struct Frame {
    LAS unsigned char* lds;
    volatile LAS unsigned* MISC;
    gu32* ctl;
    int wave;
    int vcu, G;
    int cid;
    unsigned char* ws;
    float* out;
};
__device__ __forceinline__ const float* inp(int i) {
    unsigned off = (unsigned)i * 8u; asm volatile("" : "+s"(off));
    const __attribute__((address_space(4))) char* ka = (const __attribute__((address_space(4))) char*)__builtin_amdgcn_kernarg_segment_ptr();
    return *(const float* const __attribute__((address_space(4)))*)(ka + off);
}
__device__ __forceinline__ unsigned char* launder_p(unsigned char* p) { asm volatile("" : "+s"(p)); return p; }
__device__ __forceinline__ int launder_i(int x) { asm volatile("" : "+s"(x)); return x; }
__device__ __forceinline__ bf16* wgt(unsigned char* ws, int l, size_t off) { return (bf16*)(ws + WS_W + (size_t)l * W_LAYER + off); }
__device__ __forceinline__ unsigned long long* ssbuf(unsigned char* ws, int idx) { return (unsigned long long*)(ws + WS_SS) + (size_t)idx * M; }

__device__ __forceinline__ float wave_sum(float v) {
    v += pg8::xor_lt32<1>(v); v += pg8::xor_lt32<2>(v); v += pg8::xor_lt32<4>(v); v += pg8::xor_lt32<8>(v); v += pg8::xor_lt32<16>(v); return pg8::sum32(v);
}
__device__ __forceinline__ float wave_max(float v) {
    v = fmaxf(v, pg8::xor_lt32<1>(v)); v = fmaxf(v, pg8::xor_lt32<2>(v)); v = fmaxf(v, pg8::xor_lt32<4>(v)); v = fmaxf(v, pg8::xor_lt32<8>(v)); v = fmaxf(v, pg8::xor_lt32<16>(v)); return pg8::max32(v);
}

__device__ const float kInvFreq[64] = {
    1.000000000e+00f, 8.659643531e-01f, 7.498942018e-01f, 6.493816376e-01f, 5.623413324e-01f, 4.869675338e-01f, 4.216965139e-01f, 3.651741147e-01f, 3.162277639e-01f, 2.738419771e-01f, 2.371373922e-01f, 2.053525001e-01f, 1.778279394e-01f, 1.539926529e-01f, 1.333521456e-01f, 1.154782027e-01f,
    1.000000015e-01f, 8.659642935e-02f, 7.498941571e-02f, 6.493816525e-02f, 5.623412877e-02f, 4.869675264e-02f, 4.216964915e-02f, 3.651741147e-02f, 3.162277862e-02f, 2.738419734e-02f, 2.371373586e-02f, 2.053524926e-02f, 1.778279431e-02f, 1.539926510e-02f, 1.333521493e-02f, 1.154781971e-02f,
    9.999999776e-03f, 8.659643121e-03f, 7.498942316e-03f, 6.493816618e-03f, 5.623413250e-03f, 4.869675264e-03f, 4.216964822e-03f, 3.651741426e-03f, 3.162277862e-03f, 2.738419687e-03f, 2.371373819e-03f, 2.053525066e-03f, 1.778279431e-03f, 1.539926627e-03f, 1.333521446e-03f, 1.154781901e-03f,
    1.000000047e-03f, 8.659643354e-04f, 7.498941850e-04f, 6.493816618e-04f, 5.623413017e-04f, 4.869675031e-04f, 4.216965463e-04f, 3.651741135e-04f, 3.162277862e-04f, 2.738419571e-04f, 2.371373848e-04f, 2.053525241e-04f, 1.778279402e-04f, 1.539926452e-04f, 1.333521504e-04f, 1.154782076e-04f };

__device__ __forceinline__ void conv_item(const float* W, int ldw, int src_col0, int k0, const float* gain, bf16* dst, int K, int dst_row0, LAS float* scr, int lane) {
    const int kq = lane >> 3, n4 = (lane & 7) * 4;
    f32x4 v[8];
#pragma unroll
    for (int i = 0; i < 8; ++i) v[i] = __builtin_nontemporal_load((const GAS f32x4*)(W + (size_t)(k0 + kq + 8 * i) * ldw + src_col0 + n4));
    if (gain) {
#pragma unroll
        for (int i = 0; i < 8; ++i) v[i] = v[i] * gain[k0 + kq + 8 * i];
    }
#pragma unroll
    for (int i = 0; i < 8; ++i) { LAS float* s = scr + (kq + 8 * i) * 33 + n4; s[0] = v[i][0]; s[1] = v[i][1]; s[2] = v[i][2]; s[3] = v[i][3]; }
    LDS_WAIT(); asm volatile("" ::: "memory");
    const int c = lane & 7;
#pragma unroll
    for (int j = 0; j < 4; ++j) { const int n = (lane >> 3) + 8 * j; const LAS float* s = scr + (8 * c) * 33 + n;
        v4u o; o.x = pk2(s[0 * 33], s[1 * 33]); o.y = pk2(s[2 * 33], s[3 * 33]); o.z = pk2(s[4 * 33], s[5 * 33]); o.w = pk2(s[6 * 33], s[7 * 33]);
        __builtin_nontemporal_store(o, (GAS v4u*)(dst + (size_t)(dst_row0 + n) * K + k0 + 8 * c)); }
    LDS_WAIT(); asm volatile("" ::: "memory");
}
__device__ __forceinline__ void conv_item_fp8(const float* W, int ldw, int src_col0, int k0, const float* gain, float mul, unsigned char* dst8, int K, int dst_row0, LAS float* scr, int lane) {
    const int kq = lane >> 3, n4 = (lane & 7) * 4;
    f32x4 v[8];
#pragma unroll
    for (int i = 0; i < 8; ++i) v[i] = __builtin_nontemporal_load((const GAS f32x4*)(W + (size_t)(k0 + kq + 8 * i) * ldw + src_col0 + n4));
#pragma unroll
    for (int i = 0; i < 8; ++i) v[i] = v[i] * (gain ? gain[k0 + kq + 8 * i] * mul : mul);
#pragma unroll
    for (int i = 0; i < 8; ++i) { LAS float* s = scr + (kq + 8 * i) * 33 + n4; s[0] = v[i][0]; s[1] = v[i][1]; s[2] = v[i][2]; s[3] = v[i][3]; }
    LDS_WAIT(); asm volatile("" ::: "memory");
    const int c = lane & 7;
#pragma unroll
    for (int j = 0; j < 4; ++j) { const int n = (lane >> 3) + 8 * j; const LAS float* s = scr + (8 * c) * 33 + n;
        typedef unsigned u32x2 __attribute__((ext_vector_type(2))); u32x2 o; o.x = pg8::pk4_fp8(s[0 * 33], s[1 * 33], s[2 * 33], s[3 * 33]); o.y = pg8::pk4_fp8(s[4 * 33], s[5 * 33], s[6 * 33], s[7 * 33]);
        __builtin_nontemporal_store(o, (GAS u32x2*)(dst8 + (size_t)(dst_row0 + n) * K + k0 + 8 * c)); }
    LDS_WAIT(); asm volatile("" ::: "memory");
}
__device__ __forceinline__ int qkv_src_col(int n) {
    if (n < 2560) { const int base = n < 2048 ? 0 : 2048, nn = n - base, t = nn >> 8, r = nn & 255, hf = r >> 7, j = r & 127; return base + (2 * t + (j >> 6)) * 128 + hf * 64 + (j & 63); }
    if (n >= 6144 && n < 8192) { const int base = n < 7168 ? 6144 : 7168, nn = n - base, t = nn >> 8, r = nn & 255, hf = r >> 7, j = r & 127; return base + (4 * t + (j >> 5)) * 64 + hf * 32 + (j & 31); }
    return n;
}
__device__ __forceinline__ int ffn_src_col(int n) { const int t = n >> 8, r = n & 255; return (r < 128) ? (128 * t + r) : (4096 + 128 * t + (r - 128)); }

constexpr int I_W1 = (DM / 64) * (2 * DFF / 32), I_W2 = (DFF / 64) * (DM / 32), I_QKV = (DM / 64) * (NQKV / 32), I_G = (DM / 64) * (NGATE / 32), I_A = (2048 / 64) * (DM / 32), I_B = (1024 / 64) * (DM / 32), I_O = (DM / 64) * (DM / 32);
constexpr int J_W1 = 0, J_W2 = J_W1 + I_W1, J_QKV = J_W2 + I_W2, J_G = J_QKV + I_QKV, J_A = J_G + I_G, J_B = J_A + I_A, J_C = J_B + I_B, J_O = J_C + I_B, J_W3 = J_O + I_O, J_W4 = J_W3 + I_W1, I_LAYER = J_W4 + I_W2;
__device__ __forceinline__ void convert_jobs(Frame& F, int l, int r0, int r1) {
    unsigned char* const ws = launder_p(F.ws);
    const int lane = pg8::lane_id();
    LAS float* scr = (LAS float*)(F.lds + RING_OFF + F.wave * 16384);
    const int gw = F.cid * NWAVES + F.wave, NGW = F.G * NWAVES;
    for (int rr = r0 + gw; rr < r1; rr += NGW) {
        int r = rr;
        const float* W; int ldw, K, N, kind; const float* gain = nullptr; bf16* dst; int drow = 0;
        if (r < I_W1) { W = inp(2) + (size_t)l * DM * 2 * DFF; ldw = 2 * DFF; K = DM; N = 2 * DFF; kind = 1; gain = inp(1) + l * DM; dst = wgt(ws, l, WO_W1); }
        else if ((r -= I_W1) < I_W2) { W = inp(3) + (size_t)l * DFF * DM; ldw = DM; K = DFF; N = DM; kind = 0; dst = wgt(ws, l, WO_W2); }
        else if ((r -= I_W2) < I_QKV) { W = inp(5) + (size_t)l * DM * NQKV; ldw = NQKV; K = DM; N = NQKV; kind = 2; gain = inp(4) + l * DM; dst = wgt(ws, l, WO_QG); }
        else if ((r -= I_QKV) < I_G) { W = inp(6) + (size_t)l * DM * NGATE; ldw = NGATE; K = DM; N = NGATE; kind = 3; gain = inp(4) + l * DM; dst = nullptr; }
        else if ((r -= I_G) < I_A) { W = inp(13) + (size_t)l * 2048 * DM; ldw = DM; K = 2048; N = DM; kind = 0; dst = wgt(ws, l, WO_A); }
        else if ((r -= I_A) < I_B) { W = inp(14) + (size_t)l * 1024 * DM; ldw = DM; K = 2048; N = DM; kind = 0; dst = wgt(ws, l, WO_B); }
        else if ((r -= I_B) < I_B) { W = inp(15) + (size_t)l * 1024 * DM; ldw = DM; K = 2048; N = DM; kind = 0; dst = wgt(ws, l, WO_B) + 1024; }
        else if ((r -= I_B) < I_O) { W = inp(16) + (size_t)l * DM * DM; ldw = DM; K = DM; N = DM; kind = 0; dst = wgt(ws, l, WO_O); }
        else if ((r -= I_O) < I_W1) { W = inp(18) + (size_t)l * DM * 2 * DFF; ldw = 2 * DFF; K = DM; N = 2 * DFF; kind = FFN2_FP8(l) ? 4 : 1; gain = inp(17) + l * DM; dst = wgt(ws, l, WO_W3); }
        else { r -= I_W1; W = inp(19) + (size_t)l * DFF * DM; ldw = DM; K = DFF; N = DM; kind = FFN2_FP8(l) ? 5 : 0; dst = wgt(ws, l, WO_W4); }
        const int nblk = N / 32, kb = r / nblk, nb = r - kb * nblk, n0 = 32 * nb;
        const int sc = kind == 1 ? ffn_src_col(n0) : (kind == 2 ? qkv_src_col(n0) : n0);
        if (kind == 3) conv_item_fp8(W, ldw, n0, 64 * kb, gain, 64.0f, ws + WS_WG8 + (size_t)l * WG8_LAYER, K, n0, scr, lane);
        else if (kind == 4) conv_item_fp8(W, ldw, ffn_src_col(n0), 64 * kb, gain, 64.0f, ws + WS_W3F8, K, n0, scr, lane);
        else if (kind == 5) conv_item_fp8(W, ldw, n0, 64 * kb, nullptr, 64.0f, ws + WS_W4F8, K, n0, scr, lane);
        else conv_item(W, ldw, sc, 64 * kb, gain, dst, K, drow + n0, scr, lane);
    }
}
__device__ __forceinline__ void p0_prologue(Frame& F) {
    unsigned char* const ws = launder_p(F.ws);
    const int lane = pg8::lane_id();
    const int gw = F.vcu * NWAVES + F.wave, NGW = F.G * NWAVES;
    {
        float* cosA = (float*)(ws + WS_ROPE); float* sinA = cosA + 4096 * 64; float* cosC = sinA + 4096 * 64; float* sinC = cosC + 4096 * 32;
        const int gt = gw * 64 + lane, NGT = NGW * 64;
        for (int i = gt; i < 4096 * 96; i += NGT) {
            const bool isA = i < 4096 * 64; const int j = isA ? i : i - 4096 * 64; const int pos = isA ? (j >> 6) : (j >> 5), k = isA ? (j & 63) : (j & 31);
            const float inv = kInvFreq[isA ? k : 2 * k]; const float ang = (float)pos * inv;
            const double rev = (double)ang * 0.15915494309189535; const float fr = (float)(rev - floor(rev));
            const float c = __builtin_amdgcn_cosf(fr), s = __builtin_amdgcn_sinf(fr);
            if (isA) { cosA[j] = c; sinA[j] = s; } else { cosC[j] = c; sinC[j] = s; }
        }
    }
    {
        bf16* XB = (bf16*)(ws + WS_XB); unsigned long long* ss0 = ssbuf(ws, 0);
        for (int m = gw; m < M; m += NGW) {
            const GAS f32x4* xr = (const GAS f32x4*)(inp(0) + (size_t)m * DM) + lane; GAS unsigned long long* o8 = (GAS unsigned long long*)(XB + (size_t)m * DM) + lane; float s = 0.f;
#pragma unroll 4
            for (int j = 0; j < 16; ++j) { const f32x4 v = xr[64 * j]; s += (v.x * v.x + v.y * v.y) + (v.z * v.z + v.w * v.w);
                o8[64 * j] = (unsigned long long)pk2(v.x, v.y) | ((unsigned long long)pk2(v.z, v.w) << 32); }
            s = wave_sum(s);
            if (lane == 0) ss0[m] = (unsigned long long)(s * pg8::SS_SCALE + 0.5f);
        }
    }
}

namespace att {
typedef float f32x16 __attribute__((ext_vector_type(16)));
typedef short bf16x8 __attribute__((ext_vector_type(8)));
typedef short v4i16_t __attribute__((ext_vector_type(4)));
constexpr int RS = 272  , RSV = 320  , TILE = 64 * RS, BUF = TILE + 64 * RSV  , OFF_X = 0  , OFF_FLAG = 2 * BUF;
static_assert(2 * BUF >= 65536 && OFF_FLAG + 64 <= RING_BYTES, "attention LDS map");
constexpr float NEG_DONE = -160.0f;
struct TileRegs { v4u k[2], v[2]; };
__device__ __forceinline__ void tile_load(TileRegs& r, const bf16* Kg, int ldk, const bf16* Vg, int ldv, int tid_) {
    const int tid = pg8::launder_v(tid_);
#pragma unroll
    for (int i = 0; i < 2; ++i) { const int c = tid + 512 * i, row = c >> 4, ch = c & 15;
        r.k[i] = *(const GAS v4u*)(Kg + (unsigned)(row * ldk + ch * 8)); r.v[i] = *(const GAS v4u*)(Vg + (unsigned)(row * ldv + ch * 8)); }
}
__device__ __forceinline__ void tile_store(LAS unsigned char* buf, const TileRegs& r, int tid) {
#pragma unroll
    for (int i = 0; i < 2; ++i) { const int c = tid + 512 * i, row = c >> 4, ch = c & 15;
        *(LAS v4u*)(buf + row * RS + ch * 16) = r.k[i]; *(LAS v4u*)(buf + TILE + row * RSV + ch * 16) = r.v[i]; }
}
template <int NK> __device__ __forceinline__ void qk(f32x16 (&s)[2], const LAS unsigned char* kt, const bf16x8 (&qf)[NK], int lane) {
    const int r = lane & 31, h = lane >> 5;
#pragma unroll
    for (int kvt = 0; kvt < 2; ++kvt) {
        f32x16 a = {0.f, 0.f, 0.f, 0.f, 0.f, 0.f, 0.f, 0.f, 0.f, 0.f, 0.f, 0.f, 0.f, 0.f, 0.f, 0.f};
#pragma unroll
        for (int ks = 0; ks < NK; ++ks) { const bf16x8 kf = *(const LAS bf16x8*)(kt + (32 * kvt + r) * RS + (16 * ks + 8 * h) * 2); a = __builtin_amdgcn_mfma_f32_32x32x16_bf16(kf, qf[ks], a, 0, 0, 0); }
        s[kvt] = a; }
}
__device__ __forceinline__ void pv(f32x16 (&o)[4], const f32x16 (&p)[2], const LAS unsigned char* vt, int lane) {
    const int h = lane >> 5, g = (lane >> 4) & 1, i = lane & 15;
    const LAS unsigned char* vb = vt + (4 * h + (i >> 2)) * RSV + (16 * g + 4 * (i & 3)) * 2;
#pragma unroll
    for (int kvt = 0; kvt < 2; ++kvt)
#pragma unroll
        for (int s = 0; s < 2; ++s) {
            pg8::u32x4 pw; pw.x = pg8::cvt_pk_bf16(p[kvt][8 * s + 0], p[kvt][8 * s + 1]); pw.y = pg8::cvt_pk_bf16(p[kvt][8 * s + 2], p[kvt][8 * s + 3]);
            pw.z = pg8::cvt_pk_bf16(p[kvt][8 * s + 4], p[kvt][8 * s + 5]); pw.w = pg8::cvt_pk_bf16(p[kvt][8 * s + 6], p[kvt][8 * s + 7]);
            const bf16x8 pb = __builtin_bit_cast(bf16x8, pw);
#pragma unroll
            for (int dt = 0; dt < 4; ++dt) { const LAS unsigned char* a = vb + (32 * kvt + 16 * s) * RSV + 64 * dt;
                const v4i16_t lo = __builtin_amdgcn_ds_read_tr16_b64_v4i16((LAS v4i16_t*)a), hi = __builtin_amdgcn_ds_read_tr16_b64_v4i16((LAS v4i16_t*)(a + 8 * RSV));
                const bf16x8 va = {lo.x, lo.y, lo.z, lo.w, hi.x, hi.y, hi.z, hi.w};
                o[dt] = __builtin_amdgcn_mfma_f32_32x32x16_bf16(va, pb, o[dt], 0, 0, 0); } }
}
__device__ __forceinline__ void store_ot(bf16* dst, const f32x16 (&o)[4], float scale, int hi) {
#pragma unroll
    for (int dt = 0; dt < 4; ++dt)
#pragma unroll
        for (int p = 0; p < 2; ++p) { const int r0 = 8 * p, r1 = 8 * p + 4;
            unsigned ax = pg8::cvt_pk_bf16(o[dt][r0] * scale, o[dt][r0 + 1] * scale), ay = pg8::cvt_pk_bf16(o[dt][r0 + 2] * scale, o[dt][r0 + 3] * scale);
            unsigned bx = pg8::cvt_pk_bf16(o[dt][r1] * scale, o[dt][r1 + 1] * scale), by = pg8::cvt_pk_bf16(o[dt][r1 + 2] * scale, o[dt][r1 + 3] * scale);
            { const auto r = __builtin_amdgcn_permlane32_swap(ax, bx, false, false); ax = r[0]; bx = r[1]; }
            { const auto r = __builtin_amdgcn_permlane32_swap(ay, by, false, false); ay = r[0]; by = r[1]; }
            v4u w; w.x = ax; w.y = ay; w.z = bx; w.w = by;
            *(GAS v4u*)(dst + 32 * dt + 16 * p + 8 * hi) = w; }
}
template <int NK> __device__ __forceinline__ void load_q(bf16x8 (&qf)[NK], const bf16* qrow_ptr, int hi) {
#pragma unroll
    for (int ks = 0; ks < NK; ++ks) qf[ks] = *(const GAS bf16x8*)(qrow_ptr + 16 * ks + 8 * hi);
}
#define ATT_BAR() do { asm volatile("s_waitcnt lgkmcnt(0)" ::: "memory"); __builtin_amdgcn_s_barrier(); asm volatile("" ::: "memory"); } while (0)
__device__ __forceinline__ void softmax_tile(f32x16 (&s)[2], float& m, float& lsum, f32x16 (&o)[4]) {
    float mx = -INFINITY;
#pragma unroll
    for (int kvt = 0; kvt < 2; ++kvt)
#pragma unroll
        for (int r = 0; r < 16; ++r) mx = fmaxf(mx, s[kvt][r]);
    mx = pg8::max32(mx);
    const float mn = fmaxf(m, mx);
    if (__any(mn > m)) { const float alpha = __builtin_amdgcn_exp2f(m - mn); m = mn; lsum *= alpha;
#pragma unroll
        for (int dt = 0; dt < 4; ++dt) o[dt] = o[dt] * alpha; }
    float ps = 0.f;
#pragma unroll
    for (int kvt = 0; kvt < 2; ++kvt)
#pragma unroll
        for (int r = 0; r < 16; ++r) { const float e = __builtin_amdgcn_exp2f(s[kvt][r] - m); s[kvt][r] = e; ps += e; }
    lsum += ps;
}
__device__ __forceinline__ void pv_pk(f32x16 (&o)[4], const unsigned (&pw)[16], const LAS unsigned char* vt, int lane) {
    const int h = lane >> 5, g = (lane >> 4) & 1, i = lane & 15;
    const LAS unsigned char* vb = vt + (4 * h + (i >> 2)) * RSV + (16 * g + 4 * (i & 3)) * 2;
#pragma unroll
    for (int ks = 0; ks < 4; ++ks) {
        pg8::u32x4 w; w.x = pw[4 * ks]; w.y = pw[4 * ks + 1]; w.z = pw[4 * ks + 2]; w.w = pw[4 * ks + 3];
        const bf16x8 pb = __builtin_bit_cast(bf16x8, w);
#pragma unroll
        for (int dt = 0; dt < 4; ++dt) { const LAS unsigned char* a = vb + (16 * ks) * RSV + 64 * dt;
            const v4i16_t lo = __builtin_amdgcn_ds_read_tr16_b64_v4i16((LAS v4i16_t*)a), hi = __builtin_amdgcn_ds_read_tr16_b64_v4i16((LAS v4i16_t*)(a + 8 * RSV));
            const bf16x8 va = {lo.x, lo.y, lo.z, lo.w, hi.x, hi.y, hi.z, hi.w};
            o[dt] = __builtin_amdgcn_mfma_f32_32x32x16_bf16(va, pb, o[dt], 0, 0, 0); } }
}
template <bool MASK> __device__ __forceinline__ void softmax_pk(const f32x16 (&s_)[2], unsigned (&pw)[16], float& m, float& lsum, float& alpha, int kv0, int q, int hi) {
    f32x16 s[2] = {s_[0], s_[1]};
    if (MASK) {
#pragma unroll
        for (int kvt = 0; kvt < 2; ++kvt)
#pragma unroll
            for (int r = 0; r < 16; ++r) { const int kv = kv0 + 32 * kvt + (r & 3) + 8 * (r >> 2) + 4 * hi; if (kv > q) s[kvt][r] = -INFINITY; }
    }
    float mx0 = fmaxf(fmaxf(s[0][0], s[0][1]), s[0][2]), mx1 = fmaxf(fmaxf(s[1][0], s[1][1]), s[1][2]);
#pragma unroll
    for (int r = 3; r < 15; r += 2) { mx0 = fmaxf(fmaxf(mx0, s[0][r]), s[0][r + 1]); mx1 = fmaxf(fmaxf(mx1, s[1][r]), s[1][r + 1]); }
    float mx = fmaxf(fmaxf(mx0, mx1), fmaxf(s[0][15], s[1][15]));
    mx = pg8::max32(mx);
    const float mn = mx > m + 8.0f ? mx : m;
    alpha = __builtin_amdgcn_exp2f(m - mn); m = mn;
    float ps0 = 0.f, ps1 = 0.f;
#pragma unroll
    for (int kvt = 0; kvt < 2; ++kvt)
#pragma unroll
        for (int r2 = 0; r2 < 8; ++r2) { const float e0 = __builtin_amdgcn_exp2f(s[kvt][2 * r2] - mn), e1 = __builtin_amdgcn_exp2f(s[kvt][2 * r2 + 1] - mn); ps0 += e0; ps1 += e1;
            pw[8 * kvt + r2] = pg8::cvt_pk_bf16(e0, e1); }
    lsum = lsum * alpha + (ps0 + ps1);
    asm volatile("" : "+v"(pw[0]), "+v"(pw[1]), "+v"(pw[2]), "+v"(pw[3]), "+v"(pw[4]), "+v"(pw[5]), "+v"(pw[6]), "+v"(pw[7]));
    asm volatile("" : "+v"(pw[8]), "+v"(pw[9]), "+v"(pw[10]), "+v"(pw[11]), "+v"(pw[12]), "+v"(pw[13]), "+v"(pw[14]), "+v"(pw[15]));
    asm volatile("" : "+v"(lsum), "+v"(m), "+v"(alpha));
}
#define SGB(mask, n) __builtin_amdgcn_sched_group_barrier(mask, n, 0)
__device__ __forceinline__ void c_step_pipeline() {
    SGB(0x100, 8);
#pragma unroll
    for (int i = 0; i < 24; ++i) { SGB(0x008, 1); if (i < 12) SGB(0x100, 2); else if (i < 20) SGB(0x100, 1); SGB(0x402, 6); }
}
}

__device__ __forceinline__ void attn_a(Frame& F, int l) {
    using namespace att;
    unsigned char* const ws = launder_p(F.ws);
    const bf16* QA = (const bf16*)(ws + WS_QKV); const bf16* KA = QA + (size_t)M * 2048; const bf16* VA = KA + (size_t)M * 512; bf16* OA = (bf16*)(ws + WS_OA);
    LAS unsigned char* lds = F.lds + RING_OFF;
    const int lane = pg8::lane_id(), wave = F.wave, tid = wave * 64 + lane, r32 = lane & 31, hi = lane >> 5;
    for (int u = F.vcu; u < 1024; u += F.G) {
        const int qb = u & 63, kvh = (u >> 6) & 3, b = u >> 8, hq = 4 * kvh + (wave >> 1), qw = qb * 64 + 32 * (wave & 1), q = qw + r32; const size_t qrow = (size_t)b * SEQ + q;
        bf16x8 qf[8]; load_q<8>(qf, QA + qrow * 2048 + hq * 128, hi);
        float m = inp(7)[l * 16 + hq] * 1.44269504089f, lsum = hi ? 0.f : 1.f;
        f32x16 o[4];
#pragma unroll
        for (int dt = 0; dt < 4; ++dt)
#pragma unroll
            for (int r = 0; r < 16; ++r) o[dt][r] = 0.f;
        const int t_lo = qb - 2 < 0 ? 0 : qb - 2, t_hi = qb;
        const bf16* Kb = KA + (size_t)b * SEQ * 512 + kvh * 128; const bf16* Vb = VA + (size_t)b * SEQ * 512 + kvh * 128;
        TileRegs tr; tile_load(tr, Kb + (size_t)t_lo * 64 * 512, 512, Vb + (size_t)t_lo * 64 * 512, 512, tid);
        tile_store(lds, tr, tid); ATT_BAR();
        if (t_lo < t_hi) tile_load(tr, Kb + (size_t)(t_lo + 1) * 64 * 512, 512, Vb + (size_t)(t_lo + 1) * 64 * 512, 512, tid);
        for (int t = t_lo; t <= t_hi; ++t) {
            LAS unsigned char* cur = lds + ((t - t_lo) & 1) * BUF; LAS unsigned char* nxt = lds + ((t - t_lo + 1) & 1) * BUF;
            if (t < t_hi) tile_store(nxt, tr, tid);
            if (t + 1 < t_hi) tile_load(tr, Kb + (size_t)(t + 2) * 64 * 512, 512, Vb + (size_t)(t + 2) * 64 * 512, 512, tid);
            const int kv0 = 64 * t;
            if (kv0 <= qw + 31 && kv0 + 63 > qw - 128) {
                f32x16 s[2]; qk<8>(s, cur, qf, lane);
                if (t == t_hi) {
#pragma unroll
                    for (int kvt = 0; kvt < 2; ++kvt)
#pragma unroll
                        for (int r = 0; r < 16; ++r) { const int kv = kv0 + 32 * kvt + (r & 3) + 8 * (r >> 2) + 4 * hi; if (kv > q) s[kvt][r] = -INFINITY; }
                } else if (t + 2 == t_hi) {
#pragma unroll
                    for (int kvt = 0; kvt < 2; ++kvt)
#pragma unroll
                        for (int r = 0; r < 16; ++r) { const int kv = kv0 + 32 * kvt + (r & 3) + 8 * (r >> 2) + 4 * hi; if (q - kv >= 128) s[kvt][r] = -INFINITY; }
                }
                softmax_tile(s, m, lsum, o);
                pv(o, s, cur + TILE, lane);
            }
            ATT_BAR();
        }
        const float lt = pg8::sum32(lsum);
        store_ot(OA + qrow * 2048 + hq * 128, o, 1.0f / lt, hi);
    }
}
__device__ __forceinline__ void attn_b(Frame& F, int l) {
    using namespace att;
    unsigned char* const ws = launder_p(F.ws);
    const bf16* QB = (const bf16*)(ws + WS_QKV) + (size_t)M * 3072; const bf16* KB = QB + (size_t)M * 1024; const bf16* VB = KB + (size_t)M * 1024; bf16* OB = (bf16*)(ws + WS_OA) + (size_t)M * 2048;
    LAS unsigned char* lds = F.lds + RING_OFF; volatile LAS float* flags = (volatile LAS float*)(lds + OFF_FLAG);
    const int lane = pg8::lane_id(), wave = F.wave, tid = wave * 64 + lane, r32 = lane & 31, hi = lane >> 5;
    for (int u = F.vcu; u < 512; u += F.G) {
        const int qb = u & 15, h = (u >> 4) & 7, b = u >> 7, q0 = qb * 256, qw = q0 + 32 * wave, q = qw + r32; const size_t qrow = (size_t)b * SEQ + q;
        bf16x8 qf[8]; load_q<8>(qf, QB + qrow * 1024 + h * 128, hi);
        float run = 0.f;
        f32x16 o[4];
#pragma unroll
        for (int dt = 0; dt < 4; ++dt)
#pragma unroll
            for (int r = 0; r < 16; ++r) o[dt][r] = 0.f;
        const int t_hi = qb * 4 + 3;
        const bf16* Kb = KB + (size_t)b * SEQ * 1024 + h * 128; const bf16* Vb = VB + (size_t)b * SEQ * 1024 + h * 128;
        TileRegs tr; tile_load(tr, Kb + (size_t)t_hi * 64 * 1024, 1024, Vb + (size_t)t_hi * 64 * 1024, 1024, tid);
        tile_store(lds, tr, tid); ATT_BAR();
        tile_load(tr, Kb + (size_t)(t_hi - 1) * 64 * 1024, 1024, Vb + (size_t)(t_hi - 1) * 64 * 1024, 1024, tid);
        for (int t = t_hi; t >= 0; --t) {
            const int par = (t_hi - t) & 1;
            LAS unsigned char* cur = lds + par * BUF; LAS unsigned char* nxt = lds + (par ^ 1) * BUF;
            if (t > 0) tile_store(nxt, tr, tid);
            if (t > 1) tile_load(tr, Kb + (size_t)(t - 2) * 64 * 1024, 1024, Vb + (size_t)(t - 2) * 64 * 1024, 1024, tid);
            const int kv0 = 64 * t;
            float wmax = wave_max(run);
            if (kv0 < qw + 31 && wmax >= NEG_DONE) {
                f32x16 s[2]; qk<8>(s, cur, qf, lane);
                f32x16 l1[2];
#pragma unroll
                for (int kvt = 0; kvt < 2; ++kvt)
#pragma unroll
                    for (int r = 0; r < 16; ++r) { const int kv = kv0 + 32 * kvt + (r & 3) + 8 * (r >> 2) + 4 * hi; const float z = s[kvt][r];
                        const float lb = fminf(z, 0.f) - __builtin_amdgcn_logf(1.0f + __builtin_amdgcn_exp2f(-fabsf(z))); const bool valid = kv < q;
                        s[kvt][r] = valid ? lb : -INFINITY; l1[kvt][r] = valid ? (lb - z) : 0.f; }
                float gs[8], og[8];
#pragma unroll
                for (int gi = 0; gi < 8; ++gi) { const int kvt = gi >> 2, rq = gi & 3; gs[gi] = (l1[kvt][4 * rq] + l1[kvt][4 * rq + 1]) + (l1[kvt][4 * rq + 2] + l1[kvt][4 * rq + 3]); og[gi] = pg8::xor32(gs[gi], hi); }
                float above = run;
#pragma unroll
                for (int gi = 7; gi >= 0; --gi) { const int kvt = gi >> 2, rq = gi & 3;
                    const float sg = above + (hi ? 0.f : og[gi]);
                    const float a3 = sg, a2 = a3 + l1[kvt][4 * rq + 3], a1 = a2 + l1[kvt][4 * rq + 2], a0 = a1 + l1[kvt][4 * rq + 1];
                    s[kvt][4 * rq + 3] = __builtin_amdgcn_exp2f(s[kvt][4 * rq + 3] + a3); s[kvt][4 * rq + 2] = __builtin_amdgcn_exp2f(s[kvt][4 * rq + 2] + a2);
                    s[kvt][4 * rq + 1] = __builtin_amdgcn_exp2f(s[kvt][4 * rq + 1] + a1); s[kvt][4 * rq + 0] = __builtin_amdgcn_exp2f(s[kvt][4 * rq + 0] + a0);
                    above += gs[gi] + og[gi]; }
                run = above;
                pv(o, s, cur + TILE, lane);
                wmax = wave_max(run);
            }
            if (lane == 0) flags[par * 8 + wave] = wmax;
            ATT_BAR();
            float gmax = flags[par * 8];
#pragma unroll
            for (int w = 1; w < 8; ++w) gmax = fmaxf(gmax, flags[par * 8 + w]);
            if (gmax < NEG_DONE) break;
        }
        store_ot(OB + qrow * 2048 + h * 128, o, 1.0f, hi);
        ATT_BAR();
    }
}
#define C_SLOT(j) do { const int kj_ = (j) < nt ? (j) : nt - 1, vj_ = (j) < 2 ? 0 : ((j) - 2 < nt ? (j) - 2 : nt - 1); tile_load(tr, Kb + (size_t)kj_ * 64 * 1024, 1024, Vb + (size_t)vj_ * 64 * 1024, 1024, tid); } while (0)
#define C_RESCALE() do { if (__any(alpha != 1.0f)) { _Pragma("unroll") for (int dt = 0; dt < 4; ++dt) o[dt] = o[dt] * alpha; } } while (0)
#define C_STEP(SC, SN, MASK, T) do { const int t_ = (T); LAS unsigned char* cur = lds + ((t_ + 1) & 1) * BUF; LAS unsigned char* nxt = lds + (t_ & 1) * BUF; \
        tile_store(nxt, tr, tid); C_SLOT(t_ + 3); C_RESCALE(); \
        pv_pk(o, pw, cur + TILE, lane); qk<4>(SN, cur + 128 * c, qf, lane); softmax_pk<MASK>(SC, pw, m, lsum, alpha, 64 * t_, q, hi); c_step_pipeline(); \
        ATT_BAR(); } while (0)
__device__ __forceinline__ void attn_c(Frame& F, int l) {
    using namespace att;
    unsigned char* const ws = launder_p(F.ws);
    const bf16* QC = (const bf16*)(ws + WS_QKV) + (size_t)M * 6144; const bf16* KC = QC + (size_t)M * 1024; const bf16* VC = KC + (size_t)M * 1024; bf16* OC = (bf16*)(ws + WS_OA) + (size_t)M * 2048 + 1024;
    LAS unsigned char* lds = F.lds + RING_OFF; LAS float* xch = (LAS float*)(lds + OFF_X);
    const int lane = pg8::lane_id(), wave = F.wave, tid = wave * 64 + lane, r32 = lane & 31, hi = lane >> 5, wq = wave & 3, c = wave >> 2;
    const float lam_init = 0.8f - 0.6f * expf(-0.3f * (float)l);
    const float lam = expf(wave_sum(inp(8)[l * 64 + lane] * inp(9)[l * 64 + lane])) - expf(wave_sum(inp(10)[l * 64 + lane] * inp(11)[l * 64 + lane])) + lam_init;
    const float* gptr = inp(12) + l * 128;
#define C_FETCH(p_, half_) do { const int b_ = (p_) >> 7, h_ = ((p_) >> 4) & 7, qb_ = (half_) ? 31 - ((p_) & 15) : ((p_) & 15); \
        const bf16* Kn_ = KC + (size_t)b_ * SEQ * 1024 + h_ * 128; const bf16* Vn_ = VC + (size_t)b_ * SEQ * 1024 + h_ * 128; \
        tile_load(tr, Kn_, 1024, Vn_, 1024, tid); tile_load(tr1, Kn_ + (size_t)64 * 1024, 1024, Vn_, 1024, tid); \
        load_q<4>(qf, QC + ((size_t)b_ * SEQ + qb_ * 128 + 32 * wq + r32) * 1024 + h_ * 128 + 64 * c, hi); } while (0)
    TileRegs tr, tr1; bf16x8 qf[4];
    if (F.vcu < 512) C_FETCH(F.vcu, 0);
    for (int p = F.vcu; p < 512; p += F.G) {
        const int bh = p >> 4, x = p & 15, b = bh >> 3, h = bh & 7;
        const bf16* Kb = KC + (size_t)b * SEQ * 1024 + h * 128; const bf16* Vb = VC + (size_t)b * SEQ * 1024 + h * 128;
        for (int half = 0; half < 2; ++half) {
            const int qblk = half ? 31 - x : x, q0 = qblk * 128, qw = q0 + 32 * wq, q = qw + r32; const size_t qrow = (size_t)b * SEQ + q;
            float m = -INFINITY, lsum = 0.f, alpha = 1.0f;
            f32x16 o[4];
#pragma unroll
            for (int dt = 0; dt < 4; ++dt)
#pragma unroll
                for (int r = 0; r < 16; ++r) o[dt][r] = 0.f;
            unsigned pw[16];
#pragma unroll
            for (int i = 0; i < 16; ++i) pw[i] = 0u;
            const int nt = 2 * qblk + 2;
            f32x16 sA[2], sB[2];
            tile_store(lds, tr, tid); tile_store(lds + BUF, tr1, tid); C_SLOT(2); ATT_BAR();
            qk<4>(sA, lds + 128 * c, qf, lane); ATT_BAR();
            for (int t = 0; t + 2 < nt; t += 2) { C_STEP(sA, sB, false, t); C_STEP(sB, sA, false, t + 1); }
            C_STEP(sA, sB, true, nt - 2); C_STEP(sB, sA, true, nt - 1);
            C_RESCALE(); pv_pk(o, pw, lds + ((nt + 1) & 1) * BUF + TILE, lane);
            ATT_BAR();
            const float lt = pg8::sum32(lsum);
            if (c == 1) { const float sc = lam / lt;
#pragma unroll
                for (int dt = 0; dt < 4; ++dt)
#pragma unroll
                    for (int r = 0; r < 16; ++r) xch[(wq * 64 + dt * 16 + r) * 64 + lane] = o[dt][r] * sc; }
            ATT_BAR();
            float ss = 0.f;
            if (c == 0) { const float sc = 1.0f / lt;
#pragma unroll
                for (int dt = 0; dt < 4; ++dt)
#pragma unroll
                    for (int r = 0; r < 16; ++r) { const float y = o[dt][r] * sc - xch[(wq * 64 + dt * 16 + r) * 64 + lane]; o[dt][r] = y; ss += y * y; } }
            asm volatile("" ::: "memory");
            { const int pn = half ? p + F.G : p, hn = half ^ 1; if (pn < 512) C_FETCH(pn, hn); }
            if (c == 0) {
                ss = pg8::sum32(ss);
                const float rn = rsqrtf(ss * (1.0f / 128.0f) + 1e-5f) * (1.0f - lam_init);
#pragma unroll
                for (int dt = 0; dt < 4; ++dt)
#pragma unroll
                    for (int rq = 0; rq < 4; ++rq) { const f32x4 g = *(const GAS f32x4*)(gptr + 32 * dt + 8 * rq + 4 * hi);
                        o[dt][4 * rq] *= g.x * rn; o[dt][4 * rq + 1] *= g.y * rn; o[dt][4 * rq + 2] *= g.z * rn; o[dt][4 * rq + 3] *= g.w * rn; }
                store_ot(OC + qrow * 2048 + h * 128, o, 1.0f, hi); }
            ATT_BAR();
        }
    }
}

__device__ __forceinline__ void final_norm(Frame& F) {
    unsigned char* const ws = launder_p(F.ws);
    const bf16* XB = (const bf16*)(ws + WS_XB); const float* g = inp(20); const int lane = pg8::lane_id();
    const int gw = F.vcu * NWAVES + F.wave, NGW = F.G * NWAVES;
    for (int m = gw; m < M; m += NGW) {
        const GAS v4u* xr = (const GAS v4u*)(XB + (size_t)m * DM) + lane; GAS f32x4* orow = (GAS f32x4*)(F.out + (size_t)m * DM) + 2 * lane; const GAS f32x4* gr = (const GAS f32x4*)g + 2 * lane;
        f32x4 v[16]; float s = 0.f;
#pragma unroll
        for (int j = 0; j < 8; ++j) { pg8::unpack8(xr[64 * j], v[2 * j], v[2 * j + 1]);
            s += (v[2 * j].x * v[2 * j].x + v[2 * j].y * v[2 * j].y) + (v[2 * j].z * v[2 * j].z + v[2 * j].w * v[2 * j].w) + (v[2 * j + 1].x * v[2 * j + 1].x + v[2 * j + 1].y * v[2 * j + 1].y) + (v[2 * j + 1].z * v[2 * j + 1].z + v[2 * j + 1].w * v[2 * j + 1].w); }
        const float rs = rsqrtf(wave_sum(s) * (1.0f / DM) + 1e-6f);
#pragma unroll
        for (int j = 0; j < 8; ++j) { orow[128 * j] = v[2 * j] * rs * gr[128 * j]; orow[128 * j + 1] = v[2 * j + 1] * rs * gr[128 * j + 1]; }
    }
}

#define GP(Epi) pg8::gemm_phase<Epi, pg8::StaticOrder, true, true>
__device__ __forceinline__ void ph_ffn_in(Frame& F, int l, int which) {
    unsigned char* const ws = launder_p(F.ws);
    pg8::StaticOrder S; S.init(M, 2 * DFF, launder_i(F.G), launder_i(F.cid));
    if (which && FFN2_FP8(l)) {
        pg8::Gemm g{(const bf16*)(ws + WS_XB8), (const bf16*)(ws + WS_W3F8), M, 2 * DFF, DM / 2};
        pg8::EpiSwigluT<true> E{(bf16*)(ws + WS_HID), ssbuf(ws, 3 * l + 2), {}, 1.0f / 64.0f}; { pg8::Unit u0; u0.pm = 0; u0.pn = 0; E.R.pm = -1; if (S.next(0, u0)) E.R.load(E.ss, u0.pm, F.wave, pg8::lane_id(), 1.0f / 64.0f); }
        pg8::gemm_phase<pg8::EpiSwigluT<true>, pg8::StaticOrder, true, true, true>(F.lds + RING_OFF, g, S, E, F.wave);
        return;
    }
    pg8::Gemm g{(const bf16*)(ws + WS_XB), wgt(ws, l, which ? WO_W3 : WO_W1), M, 2 * DFF, DM};
    pg8::EpiSwiglu E{(bf16*)(ws + WS_HID), ssbuf(ws, 3 * l + (which ? 2 : 0)), {}, 1.0f}; { pg8::Unit u0; u0.pm = 0; u0.pn = 0; E.R.pm = -1; if (S.next(0, u0)) E.R.load(E.ss, u0.pm, F.wave, pg8::lane_id(), 1.0f); }
    GP(pg8::EpiSwiglu)(F.lds + RING_OFF, g, S, E, F.wave);
}
__device__ __forceinline__ void ph_ffn_out(Frame& F, int l, int which) {
    unsigned char* const ws = launder_p(F.ws);
    pg8::Gemm g{(const bf16*)(ws + WS_HID), wgt(ws, l, which ? WO_W4 : WO_W2), M, DM, DFF}; pg8::StaticOrder S; S.init(M, DM, launder_i(F.G), launder_i(F.cid));
    if (which == 0) {
        pg8::EpiResid<true> E{l == 0 ? inp(0) : nullptr, (bf16*)(ws + WS_XB), ssbuf(ws, 3 * l + 1), 0.5f, (long)WS_XB8 - (long)WS_XB};
        GP(pg8::EpiResid<true>)(F.lds + RING_OFF, g, S, E, F.wave);
    } else if (FFN2_FP8(l)) {
        pg8::Gemm g8{(const bf16*)(ws + WS_HID), (const bf16*)(ws + WS_W4F8), M, DM, DFF / 2};
        pg8::EpiResid<false> E{nullptr, (bf16*)(ws + WS_XB), ssbuf(ws, 3 * (l + 1)), 0.5f / 64.0f, 0};
        pg8::gemm_phase<pg8::EpiResid<false>, pg8::StaticOrder, true, true, true>(F.lds + RING_OFF, g8, S, E, F.wave);
    } else {
        pg8::EpiResid<false> E{nullptr, (bf16*)(ws + WS_XB), ssbuf(ws, 3 * (l + 1)), 0.5f, 0};
        GP(pg8::EpiResid<false>)(F.lds + RING_OFF, g, S, E, F.wave);
    }
}
__device__ __forceinline__ void ph_qkvg(Frame& F, int l) {
    unsigned char* const ws = launder_p(F.ws);
    pg8::Gemm g{(const bf16*)(ws + WS_XB), wgt(ws, l, WO_QG), M, NQKV, DM}; pg8::StaticOrder S; S.init(M, NQKV, launder_i(F.G), launder_i(F.cid));
    const float* cosA = (const float*)(ws + WS_ROPE);
    pg8::EpiQKVG E{(bf16*)(ws + WS_QKV), (bf16*)(ws + WS_GATES), ssbuf(ws, 3 * l + 1), cosA, cosA + 4096 * 64, cosA + 2 * 4096 * 64, cosA + 2 * 4096 * 64 + 4096 * 32, {}}; { pg8::Unit u0; u0.pm = 0; u0.pn = 0; E.R.pm = -1; if (S.next(0, u0)) E.R.load(E.ss, u0.pm, F.wave, pg8::lane_id(), 1.0f); }
    GP(pg8::EpiQKVG)(F.lds + RING_OFF, g, S, E, F.wave);
}
__device__ __forceinline__ void ph_gates(Frame& F, int l) {
    unsigned char* const ws = launder_p(F.ws);
    pg8::Gemm g{(const bf16*)(ws + WS_XB8), (const bf16*)(ws + WS_WG8 + (size_t)l * WG8_LAYER), M, NGATE, DM / 2}; pg8::StaticOrder S; S.init(M, NGATE, launder_i(F.G), launder_i(F.cid));
    pg8::EpiGates E{ws + WS_GATES, ssbuf(ws, 3 * l + 1), {}}; { pg8::Unit u0; u0.pm = 0; u0.pn = 0; E.R.pm = -1; if (S.next(0, u0)) E.R.load(E.ss, u0.pm, F.wave, pg8::lane_id(), 1.0f / 64.0f); }
    pg8::gemm_phase<pg8::EpiGates, pg8::StaticOrder, true, true, true>(F.lds + RING_OFF, g, S, E, F.wave);
}
__device__ __forceinline__ void ph_branches(Frame& F, int l) {
    unsigned char* const ws = launder_p(F.ws);
    const bf16* OA = (const bf16*)(ws + WS_OA);
    pg8::MergeGemm g{OA, OA + (size_t)M * 2048, wgt(ws, l, WO_A), wgt(ws, l, WO_B), ws + WS_GATES, (bf16*)(ws + WS_MB)};
    pg8::StaticOrder S; S.init(M, DM, launder_i(F.G), launder_i(F.cid));
    pg8::gemm_phase_merge(F.lds + RING_OFF, g, S, F.wave);
}
__device__ __forceinline__ void ph_wout(Frame& F, int l) {
    unsigned char* const ws = launder_p(F.ws);
    pg8::Gemm g{(const bf16*)(ws + WS_MB), wgt(ws, l, WO_O), M, DM, DM}; pg8::StaticOrder S; S.init(M, DM, launder_i(F.G), launder_i(F.cid));
    if (FFN2_FP8(l)) { pg8::EpiResid<true> E{nullptr, (bf16*)(ws + WS_XB), ssbuf(ws, 3 * l + 2), 1.0f, (long)WS_XB8 - (long)WS_XB}; GP(pg8::EpiResid<true>)(F.lds + RING_OFF, g, S, E, F.wave); return; }
    pg8::EpiResid<false> E{nullptr, (bf16*)(ws + WS_XB), ssbuf(ws, 3 * l + 2), 1.0f, 0};
    GP(pg8::EpiResid<false>)(F.lds + RING_OFF, g, S, E, F.wave);
}

__global__ void __launch_bounds__(NWAVES * 64, 2) mk_fwd(Args args) {
    extern __shared__ __attribute__((aligned(16))) unsigned char lds[];
    Frame F;
    F.lds = (LAS unsigned char*)lds;
    F.MISC = (volatile LAS unsigned*)(F.lds + MISC_OFF);
    F.wave = __builtin_amdgcn_readfirstlane((int)threadIdx.x >> 6); asm volatile("" : "+s"(F.wave));
    F.G = gridDim.x; { const int bx = blockIdx.x; F.vcu = (F.G % 8 == 0) ? (bx % 8) * (F.G / 8) + bx / 8 : bx; }
    F.ws = args.ws; F.out = args.out;
    F.ctl = (gu32*)(args.ws + WS_CTL);
    for (int u = threadIdx.x; u < (LDS_BYTES - LDSCTL_OFF) / 4; u += NWAVES * 64) ((LAS unsigned*)(F.lds + LDSCTL_OFF))[u] = 0u;
    __syncthreads();
#if MK_PER_PHASE
    const int lo = args.ph_lo, hi = args.ph_hi;
#else
    constexpr int lo = 0, hi = NPH;
#endif
    XcdBarrier bar; bar.bar = (unsigned*)(F.ctl + CW_BAR) + args.li * XCD_BAR_WORDS; bar.x = 0; bar.st = nullptr;
    if (hi - lo > 1) bar = xcd_barrier_post((unsigned*)(F.ctl + CW_BAR) + args.li * XCD_BAR_WORDS, F.MISC + 8);
    F.cid = blockIdx.x;
    if (hi - lo > 1 && F.wave == 0 && pg8::lane_id() == 0) { const unsigned x = xb_xcc_id(); F.MISC[10] = x; F.MISC[11] = xb_add((unsigned*)(F.ctl + CW_TICKET) + 64 * x, 1u); }
#define IN(k) (lo <= (k) && (k) < hi)
#define SEAM(k) do { if (IN(k) && IN((k) + 1)) xcd_barrier(bar, F.wave); } while (0)

    if (IN(0)) { p0_prologue(F); convert_jobs(F, 0, J_W1, J_W2); SEAM(0); }
    if (hi - lo > 1) {
        if (F.wave == 0 && pg8::lane_id() == 0) { unsigned ok = (F.G % 8 == 0) ? 1u : 0u; unsigned* bw = (unsigned*)(F.ctl + CW_BAR) + args.li * XCD_BAR_WORDS;
            for (unsigned j = 0; j < 16; ++j) { const unsigned c = xb_ld(&bw[XB_XCNT(j)]); ok &= (c == (j < 8 ? (unsigned)F.G / 8u : 0u)) ? 1u : 0u; }
            F.MISC[12] = ok; }
        __syncthreads();
        if (F.MISC[12]) { const int x = (int)F.MISC[10], r = (int)F.MISC[11]; F.cid = __builtin_amdgcn_readfirstlane(r * 8 + x); F.vcu = __builtin_amdgcn_readfirstlane(x * (F.G / 8) + r); }
    }
    for (int l = 0; l < DEPTH; ++l) {
        const int pb = 1 + 8 * l; const bool cf = (F.cid & 1) != 0;
#define CONV(first, lyr, a, b) do { if ((first) == cf) { convert_jobs(F, lyr, a, b); if (first) __syncthreads(); } } while (0)
        if (IN(pb + 0)) { CONV(true, l, J_W2, J_QKV); ph_ffn_in(F, l, 0); CONV(false, l, J_W2, J_QKV); SEAM(pb + 0); }
        if (IN(pb + 1)) { CONV(true, l, J_QKV, J_A); ph_ffn_out(F, l, 0); CONV(false, l, J_QKV, J_A); SEAM(pb + 1); }
        if (IN(pb + 2)) { ph_qkvg(F, l); ph_gates(F, l); SEAM(pb + 2); }
        if (IN(pb + 3)) { CONV(true, l, J_A, J_O); attn_a(F, l); attn_b(F, l); attn_c(F, l); CONV(false, l, J_A, J_O); SEAM(pb + 3); }
        if (IN(pb + 4)) { CONV(true, l, J_O, J_W3); ph_branches(F, l); CONV(false, l, J_O, J_W3); SEAM(pb + 4); }
        if (IN(pb + 5)) { CONV(true, l, J_W3, J_W4); ph_wout(F, l); CONV(false, l, J_W3, J_W4); SEAM(pb + 5); }
        if (IN(pb + 6)) { CONV(true, l, J_W4, I_LAYER); ph_ffn_in(F, l, 1); CONV(false, l, J_W4, I_LAYER); SEAM(pb + 6); }
        if (IN(pb + 7)) { if (l + 1 < DEPTH) CONV(true, l + 1, J_W1, J_W2); ph_ffn_out(F, l, 1); if (l + 1 < DEPTH) CONV(false, l + 1, J_W1, J_W2); SEAM(pb + 7); }
#undef CONV
    }
    if (IN(NPH - 1)) final_norm(F);
#undef IN
#undef SEAM
}

extern "C" void kernel_launch(void* const* d_in, const int* in_sizes, int n_in, void* d_out, int out_size, void* d_ws, size_t ws_size, hipStream_t stream) {
    static int grid = 0;
    if (grid == 0) {
        if (n_in != 21 || in_sizes[0] != M * DM || out_size != M * DM || ws_size < WS_END) { fprintf(stderr, "kernel_launch: unexpected shapes (n_in %d, in0 %d, out %d, ws %zu < %zu); nothing launched\n", n_in, n_in > 0 ? in_sizes[0] : -1, out_size, ws_size, (size_t)WS_END); grid = -1; return; }
        int dev = 0, cus = 0, per_cu = 0;
        if (hipGetDevice(&dev) != hipSuccess || hipDeviceGetAttribute(&cus, hipDeviceAttributeMultiprocessorCount, dev) != hipSuccess) { grid = -1; return; }
        if (hipFuncSetAttribute((const void*)mk_fwd, hipFuncAttributeMaxDynamicSharedMemorySize, LDS_BYTES) != hipSuccess) { fprintf(stderr, "kernel_launch: hipFuncSetAttribute failed\n"); grid = -1; return; }
        if (hipOccupancyMaxActiveBlocksPerMultiprocessor(&per_cu, (const void*)mk_fwd, NWAVES * 64, LDS_BYTES) != hipSuccess || per_cu < 1) fprintf(stderr, "kernel_launch: occupancy query reports %d\n", per_cu);
        (void)hipGetLastError();
        grid = cus;
    }
    if (grid < 0) return;
    if (hipMemsetAsync((char*)d_ws + WS_CTL, 0, CTL_ZERO_BYTES, stream) != hipSuccess) { fprintf(stderr, "kernel_launch: hipMemsetAsync failed\n"); return; }
    Args a{};
    for (int i = 0; i < 21; ++i) a.in[i] = (const float*)d_in[i];
    a.out = (float*)d_out; a.ws = (unsigned char*)d_ws; a.pad = 0;
#if MK_PER_PHASE
    for (int p = 0; p < NPH; ++p) { a.ph_lo = p; a.ph_hi = p + 1; a.li = 0; hipLaunchKernelGGL(mk_fwd, dim3(grid), dim3(NWAVES * 64), LDS_BYTES, stream, a); }
#else
    a.ph_lo = 0; a.ph_hi = NPH; a.li = 0;
    hipLaunchKernelGGL(mk_fwd, dim3(grid), dim3(NWAVES * 64), LDS_BYTES, stream, a);
#endif
    const hipError_t le = hipPeekAtLastError();
    if (le != hipSuccess) fprintf(stderr, "kernel_launch: launch failed: %s\n", hipGetErrorName(le));
}
```
